# Optimizing an MI355X kernel written in HIP

```python
import jax, jax.numpy as jnp
from jax import lax
import numpy as np

D_MODEL = 4096
BATCH = 1
SEQ = 8192
DEPTH = 4

CONF_WIDTH = 768
CONF_KERNEL = 31
SC_WIDTH = 768
SC_KERNEL = 3
HEAD_DIM = 64
N_Q_HEADS = 24
N_KV_HEADS = 4
GQA_GROUP = N_Q_HEADS // N_KV_HEADS
ATTN_WIDTH = N_Q_HEADS * HEAD_DIM
KV_WIDTH = N_KV_HEADS * HEAD_DIM
WINDOW = 128
BLOCK = 128

MIX_WIDTH = CONF_WIDTH + SC_WIDTH + ATTN_WIDTH
D_FF = 4 * D_MODEL
N_GATES = 3
N_IN = 2 * CONF_WIDTH + 3 * SC_WIDTH + ATTN_WIDTH + 2 * KV_WIDTH + N_GATES * D_MODEL
DEEPNORM_ALPHA = (2 * DEPTH) ** 0.25
DEEPNORM_BETA = (8 * DEPTH) ** -0.25
LN_EPS = 1e-5

kernel_name = "hybrid_conformer_shortconv_swa_deepnorm"


def _split_points():
    sizes = [CONF_WIDTH, CONF_WIDTH, SC_WIDTH, SC_WIDTH, SC_WIDTH,
             ATTN_WIDTH, KV_WIDTH, KV_WIDTH, D_MODEL, D_MODEL, D_MODEL]
    return np.cumsum(sizes)[:-1].tolist()


def alibi_slopes(n):
    def pow2(m):
        start = 2.0 ** (-8.0 / m)
        return [start ** (i + 1) for i in range(m)]
    if (n & (n - 1)) == 0:
        s = pow2(n)
    else:
        c = 2 ** int(np.floor(np.log2(n)))
        s = pow2(c) + pow2(2 * c)[0::2][: n - c]
    return jnp.asarray(np.array(s, dtype=np.float32))


def layer_norm(x, g, b):
    x32 = x.astype(jnp.float32)
    mu = jnp.mean(x32, axis=-1, keepdims=True)
    var = jnp.mean(jnp.square(x32 - mu), axis=-1, keepdims=True)
    y = (x32 - mu) * lax.rsqrt(var + LN_EPS) * g.astype(jnp.float32) + b.astype(jnp.float32)
    return y.astype(x.dtype)


def causal_depthwise_conv(u, w):
    k, c = w.shape
    return lax.conv_general_dilated(
        u, w[:, None, :].astype(u.dtype), window_strides=(1,), padding=[(k - 1, 0)],
        dimension_numbers=('NWC', 'WIO', 'NWC'), feature_group_count=c)


def sliding_window_attention(q, k, v, sinks):
    b, s, _ = q.shape
    nb = s // BLOCK
    qb = q.reshape(b, nb, BLOCK, N_KV_HEADS, GQA_GROUP, HEAD_DIM)

    def band(t):
        t = t.reshape(b, s, N_KV_HEADS, HEAD_DIM)
        t = jnp.pad(t, ((0, 0), (BLOCK, 0), (0, 0), (0, 0))).reshape(b, nb + 1, BLOCK, N_KV_HEADS, HEAD_DIM)
        return jnp.concatenate([t[:, :-1], t[:, 1:]], axis=2)

    kb, vb = band(k), band(v)
    scores = jnp.einsum('bnqkgd,bnskd->bnkgqs', qb, kb,
                        preferred_element_type=jnp.float32) * (HEAD_DIM ** -0.5)
    qi = jnp.arange(BLOCK)[:, None]
    si = jnp.arange(2 * BLOCK)[None, :]
    dist = BLOCK + qi - si
    key_pos = (jnp.arange(nb)[:, None] - 1) * BLOCK + jnp.arange(2 * BLOCK)[None, :]
    mask = ((dist >= 0) & (dist < WINDOW))[None] & (key_pos >= 0)[:, None, :]
    slopes = alibi_slopes(N_Q_HEADS).reshape(N_KV_HEADS, GQA_GROUP)
    bias = -slopes[:, :, None, None] * dist.astype(jnp.float32)[None, None]
    scores = jnp.where(mask[None, :, None, None], scores + bias[None, None], -jnp.inf)
    sink = sinks.astype(jnp.float32).reshape(N_KV_HEADS, GQA_GROUP)[None, None, :, :, None, None]
    m = jnp.maximum(jnp.max(scores, axis=-1, keepdims=True), sink)
    e = jnp.exp(scores - m)
    probs = e / (jnp.sum(e, axis=-1, keepdims=True) + jnp.exp(sink - m))
    out = jnp.einsum('bnkgqs,bnskd->bnqkgd', probs.astype(v.dtype), vb)
    return out.reshape(b, s, ATTN_WIDTH)


def setup_inputs(seed: int = 0) -> dict:
    key = jax.random.key(seed)
    ks = jax.random.split(key, 26)
    f32 = jnp.float32

    def nrm(k, shape, scale):
        return jax.random.normal(k, shape, f32) * scale

    L = DEPTH
    w_branch = jnp.concatenate([
        nrm(ks[8], (L, CONF_WIDTH, D_MODEL), CONF_WIDTH ** -0.5 * DEEPNORM_BETA),
        nrm(ks[9], (L, SC_WIDTH, D_MODEL), SC_WIDTH ** -0.5 * DEEPNORM_BETA),
        nrm(ks[10], (L, ATTN_WIDTH, D_MODEL), ATTN_WIDTH ** -0.5 * DEEPNORM_BETA)], axis=1)
    return {
        "x": nrm(ks[0], (BATCH, SEQ, D_MODEL), 1.0),
        "w_in": nrm(ks[1], (L, D_MODEL, N_IN), D_MODEL ** -0.5),
        "b_in": nrm(ks[2], (L, N_IN), 0.02),
        "conf_dw_w": nrm(ks[3], (L, CONF_KERNEL, CONF_WIDTH), CONF_KERNEL ** -0.5),
        "conf_dw_b": nrm(ks[4], (L, CONF_WIDTH), 0.02),
        "conf_ln_g": 1.0 + nrm(ks[5], (L, CONF_WIDTH), 0.02),
        "conf_ln_b": nrm(ks[6], (L, CONF_WIDTH), 0.02),
        "sc_dw_w": nrm(ks[7], (L, SC_KERNEL, SC_WIDTH), SC_KERNEL ** -0.5),
        "attn_sinks": nrm(ks[11], (L, N_Q_HEADS), 0.5),
        "w_branch": w_branch,
        "w_out": nrm(ks[12], (L, D_MODEL, D_MODEL), D_MODEL ** -0.5 * DEEPNORM_BETA),
        "b_out": nrm(ks[13], (L, D_MODEL), 0.02),
        "ln1_g": 1.0 + nrm(ks[14], (L, D_MODEL), 0.02),
        "ln1_b": nrm(ks[15], (L, D_MODEL), 0.02),
        "w_mlp1": nrm(ks[16], (L, D_MODEL, D_FF), D_MODEL ** -0.5),
        "b_mlp1": nrm(ks[17], (L, D_FF), 0.02),
        "w_mlp2": nrm(ks[18], (L, D_FF, D_MODEL), D_FF ** -0.5 * DEEPNORM_BETA),
        "b_mlp2": nrm(ks[19], (L, D_MODEL), 0.02),
        "ln2_g": 1.0 + nrm(ks[20], (L, D_MODEL), 0.02),
        "ln2_b": nrm(ks[21], (L, D_MODEL), 0.02),
    }


def reference(x, w_in, b_in, conf_dw_w, conf_dw_b, conf_ln_g, conf_ln_b, sc_dw_w, attn_sinks,
              w_branch, w_out, b_out, ln1_g, ln1_b, w_mlp1, b_mlp1, w_mlp2, b_mlp2, ln2_g, ln2_b):
    splits = _split_points()
    a0, a1 = 0, CONF_WIDTH
    b0, b1 = CONF_WIDTH, CONF_WIDTH + SC_WIDTH
    c0 = CONF_WIDTH + SC_WIDTH
    for l in range(DEPTH):
        proj = jnp.einsum('bsd,dn->bsn', x, w_in[l]) + b_in[l]
        (conf_a, conf_g, sc_b, sc_c, sc_x, q, k, v,
         gate_a, gate_b, gate_c) = jnp.split(proj, splits, axis=-1)

        u = conf_a * jax.nn.sigmoid(conf_g)
        u = causal_depthwise_conv(u, conf_dw_w[l]) + conf_dw_b[l]
        y_a = jax.nn.silu(layer_norm(u, conf_ln_g[l], conf_ln_b[l]))

        y_b = sc_b * causal_depthwise_conv(sc_c * sc_x, sc_dw_w[l])

        y_c = sliding_window_attention(q, k, v, attn_sinks[l])

        wb = w_branch[l]
        p_a = jnp.einsum('bsc,cd->bsd', y_a, wb[a0:a1])
        p_b = jnp.einsum('bsc,cd->bsd', y_b, wb[b0:b1])
        p_c = jnp.einsum('bsc,cd->bsd', y_c, wb[c0:])
        merged = (jax.nn.sigmoid(gate_a) * p_a + jax.nn.sigmoid(gate_b) * p_b
                  + jax.nn.sigmoid(gate_c) * p_c)
        mix = jnp.einsum('bsd,de->bse', merged, w_out[l]) + b_out[l]
        x = layer_norm(DEEPNORM_ALPHA * x + mix, ln1_g[l], ln1_b[l])

        hid = jnp.square(jax.nn.relu(jnp.einsum('bsd,df->bsf', x, w_mlp1[l]) + b_mlp1[l]))
        ff = jnp.einsum('bsf,fd->bsd', hid, w_mlp2[l]) + b_mlp2[l]
        x = layer_norm(DEEPNORM_ALPHA * x + ff, ln2_g[l], ln2_b[l])
    return x
```

```cpp
#include <hip/hip_runtime.h>
#include <cstdio>
#include <cstdint>

#ifndef MK_ONE_LAUNCH
#define MK_ONE_LAUNCH 1
#endif

#define GAS __attribute__((address_space(1)))
#define LAS __attribute__((address_space(3)))
typedef unsigned short bf16_t;
typedef short bf16x8 __attribute__((ext_vector_type(8)));
typedef float f32x4 __attribute__((ext_vector_type(4)));
typedef float f32x2 __attribute__((ext_vector_type(2)));
typedef unsigned u32x4 __attribute__((ext_vector_type(4)));
typedef unsigned u32x2 __attribute__((ext_vector_type(2)));

constexpr int S = 8192, D = 4096, DEPTH = 4, CW = 768, AW = 1536, KVW = 256, NIN = 18176, FF = 16384, MIXW = 3072, NG = 3 * D;
constexpr int NQH = 24, HD = 64;
constexpr float LN_EPS = 1e-5f;
constexpr float ALPHA = 1.681792830507429f;
constexpr float L2E = 1.4426950408889634f;
constexpr float QSCALE = 0.125f * L2E;

constexpr size_t MiB = 1u << 20;
constexpr size_t WS_CTL = 0, CTL_ZERO_BYTES = 1 * MiB;
constexpr size_t WS_BIASP = 1 * MiB;
constexpr size_t WS_XB = 2 * MiB;
constexpr size_t WS_X1B = WS_XB + 64 * MiB;
constexpr size_t WS_XF = WS_X1B + 64 * MiB;
constexpr size_t WS_X1F = WS_XF + 128 * MiB;
constexpr size_t WS_V = WS_X1F + 128 * MiB;
constexpr size_t WS_U = WS_V + 128 * MiB;
constexpr size_t WS_CX = WS_U + 12 * MiB;
constexpr size_t WS_SB = WS_CX + 12 * MiB;
constexpr size_t WS_Q = WS_SB + 12 * MiB;
constexpr size_t WS_K = WS_Q + 24 * MiB;
constexpr size_t WS_VT = WS_K + 4 * MiB;
constexpr size_t WS_SG = WS_VT + 4 * MiB;
constexpr size_t WS_Y = WS_SG + 192 * MiB;
constexpr size_t WS_MG = WS_Y + 48 * MiB;
constexpr size_t WS_HID = WS_MG + 64 * MiB;
constexpr size_t WS_W = WS_HID + 256 * MiB;
constexpr size_t W_IN_B = (size_t)NIN * D * 2, W_B_B = (size_t)D * MIXW * 2, W_O_B = (size_t)D * D * 2, W_1_B = (size_t)FF * D * 2, W_2_B = (size_t)D * FF * 2;
constexpr size_t W_LAYER_B = W_IN_B + W_B_B + W_O_B + W_1_B + W_2_B;
constexpr size_t WS_END = WS_W + DEPTH * W_LAYER_B;
constexpr int CW_BAR = 4096;

constexpr int RING_BYTES = 131072;
constexpr int MISC_OFF = RING_BYTES + 320;
constexpr int LDS_BYTES = 147456;

#define LDS_WAIT() asm volatile("s_waitcnt lgkmcnt(0)" ::: "memory")
#define VM_WAIT() asm volatile("s_waitcnt vmcnt(0)" ::: "memory")

__device__ __forceinline__ unsigned cvt_pk_bf16(float lo, float hi) { unsigned r; asm volatile("v_cvt_pk_bf16_f32 %0, %1, %2" : "=v"(r) : "v"(lo), "v"(hi)); return r; }
__device__ __forceinline__ float bf_lo(unsigned u) { return __builtin_bit_cast(float, u << 16); }
__device__ __forceinline__ float bf_hi(unsigned u) { return __builtin_bit_cast(float, u & 0xffff0000u); }
__device__ __forceinline__ float sigmoidf_fast(float x) { return __builtin_amdgcn_rcpf(1.f + __builtin_amdgcn_exp2f(-L2E * x)); }
__device__ __forceinline__ float wave_sum(float v) {
#pragma unroll
    for (int o = 1; o < 64; o <<= 1) v += __shfl_xor(v, o);
    return v;
}

#define XB_TMO      128
#define XB_XCNT(j)  (256  + 64 * (j))
#define XB_XSUB(j)  (1280 + 64 * (j))
#define XB_XGEN(j)  (2304 + 64 * (j))
#define XB_TOP      3328
#define XB_TOPGEN   3392
#define XCD_BAR_WORDS 3456
#define XB_SPIN_CAP (1u << 20)

__device__ __forceinline__ unsigned xb_ld(unsigned* p)              { return __hip_atomic_load(p, __ATOMIC_RELAXED, __HIP_MEMORY_SCOPE_AGENT); }
__device__ __forceinline__ unsigned xb_add(unsigned* p, unsigned v) { return __hip_atomic_fetch_add(p, v, __ATOMIC_RELAXED, __HIP_MEMORY_SCOPE_AGENT); }
__device__ __forceinline__ unsigned xb_xcc_id() { return (unsigned)__builtin_amdgcn_s_getreg((3 << 11) | 20) & 0xFu; }
#define XB_SPIN(cond, bar) do { unsigned _sp = 0; while (cond) { __builtin_amdgcn_s_sleep(1); \
    if ((++_sp & 255u) == 0u) { if (xb_ld(&(bar)[XB_TMO])) break; if (_sp > XB_SPIN_CAP) { atomicAdd(&(bar)[XB_TMO], 1u); break; } } } } while (0)

struct XcdBarrier { unsigned* bar; unsigned x; volatile LAS unsigned* st; };

__device__ __forceinline__ XcdBarrier xcd_barrier_post(unsigned* bar, volatile LAS unsigned* st) {
    XcdBarrier b; b.bar = bar; b.x = xb_xcc_id(); b.st = st;
    if (threadIdx.x == 0) (void)xb_add(&bar[XB_XCNT(b.x)], 1u);
    return b;
}
__device__ __forceinline__ void xcd_barrier_complete(unsigned* bar, unsigned x, unsigned& nloc, unsigned& nx) {
    const unsigned G = gridDim.x * gridDim.y * gridDim.z;
    unsigned sum, cnt, mine, sp = 0u;
    for (;;) {
        sum = 0u; cnt = 0u; mine = 0u;
#pragma unroll
        for (unsigned j = 0; j < 16; ++j) { const unsigned c = xb_ld(&bar[XB_XCNT(j)]); sum += c; cnt += (c > 0u) ? 1u : 0u; mine = (j == x) ? c : mine; }
        if (sum == G) break;
        __builtin_amdgcn_s_sleep(1);
        if ((++sp & 255u) == 0u) { if (xb_ld(&bar[XB_TMO])) break; if (sp > XB_SPIN_CAP) { atomicAdd(&bar[XB_TMO], 1u); break; } }
    }
    nloc = mine > 0u ? mine : 1u; nx = cnt > 0u ? cnt : 1u;
}
__device__ __forceinline__ void xcd_barrier(const XcdBarrier& b) {
    asm volatile("s_waitcnt vmcnt(0)" ::: "memory");
    __syncthreads();
    if (threadIdx.x == 0) {
        unsigned* bar = b.bar;
        __builtin_amdgcn_s_waitcnt(0);
        unsigned nloc = b.st[0], nx = b.st[1];
        if (nloc == 0u) { xcd_barrier_complete(bar, b.x, nloc, nx); b.st[0] = nloc; b.st[1] = nx; }
        const unsigned old = xb_add(&bar[XB_XSUB(b.x)], 1u);
        const unsigned gen = old / nloc;
        if (old + 1u == (gen + 1u) * nloc) {
            __builtin_amdgcn_fence(__ATOMIC_RELEASE, "agent");
            asm volatile("s_waitcnt vmcnt(0)" ::: "memory");
            const unsigned og = xb_add(&bar[XB_TOP], 1u);
            const unsigned tg = og / nx;
            if (og + 1u == (tg + 1u) * nx) xb_add(&bar[XB_TOPGEN], 1u);
            else XB_SPIN(xb_ld(&bar[XB_TOPGEN]) == tg, bar);
            __builtin_amdgcn_fence(__ATOMIC_ACQUIRE, "agent");
            xb_add(&bar[XB_XGEN(b.x)], 1u);
            asm volatile("s_waitcnt vmcnt(0)" ::: "memory");
        } else {
            XB_SPIN(xb_ld(&bar[XB_XGEN(b.x)]) == gen, bar);
            __builtin_amdgcn_fence(__ATOMIC_ACQUIRE, "agent");
            asm volatile("s_waitcnt vmcnt(0)" ::: "memory");
        }
    }
    __syncthreads();
}

namespace pg8 {
constexpr int BM = 256, BK = 64, HALF = 128, HTB = HALF * BK * 2, NXCD = 8, WGM = 8;
__host__ __device__ __forceinline__ int lds_byte(int r, int c) { const int st = (r >> 4) * 2 + (c >> 5), rr = r & 15, cc = c & 31, ob = rr * 64 + cc * 2; return st * 1024 + (ob ^ (((ob >> 9) & 1) << 5)); }
__host__ __device__ __forceinline__ void stage_rc(int b, int& R, int& C) { const int st = b / 1024, sb = b % 1024, swz = sb ^ (((sb >> 9) & 1) << 5); R = (st >> 1) * 16 + swz / 64; C = (st & 1) * 32 + (swz % 64) / 2; }
__host__ __device__ __forceinline__ int perm32(int rho) { const int n = rho >> 4, i = rho & 15; return 8 * (i >> 2) + 4 * n + (i & 3); }

struct Unit { int pm, pn; };
struct Gemm { const bf16_t* A; const bf16_t* Bt; int lda, ldb, K; };

struct StaticOrder {
    int nM, nN, nwg, G, c;
    __device__ void init(int M, int N, int G_, int c_) { nM = M / BM; nN = N / BM; nwg = nM * nN; G = G_; c = c_; }
    __device__ bool next(int i, Unit& u) const {
        const long L = (long)i * G + c; if (L >= nwg) return false;
        int wgid = (int)L; { const int q = nwg / NXCD, r = nwg % NXCD, xcd = wgid % NXCD, off = wgid / NXCD; wgid = (xcd < r ? xcd * (q + 1) : r * (q + 1) + (xcd - r) * q) + off; }
        const int nig = WGM * nN, gid = wgid / nig, fm = gid * WGM, gsz = (nM - fm) < WGM ? (nM - fm) : WGM;
        u.pm = fm + ((wgid % nig) % gsz); u.pn = (wgid % nig) / gsz; return true;
    }
};

template <class Epi, bool MID>
__device__ __forceinline__ void gemm_phase(LAS unsigned char* lds, const Gemm g, const StaticOrder& S, const Epi& E, const int tid) {
    const int wid = __builtin_amdgcn_readfirstlane(tid >> 6), lane = tid & 63, wr = wid >> 2, wc = wid & 3, fr = lane & 15, fq = lane >> 4;
    const int nt = g.K / BK;
    unsigned voffA[2], voffB[2];
#pragma unroll
    for (int i = 0; i < 2; ++i) { int R, C; stage_rc(tid * 16 + i * 8192, R, C); const int Rb = (R & ~31) + perm32(R & 31);
        voffA[i] = (unsigned)(R * g.lda + C) * 2u; voffB[i] = (unsigned)(Rb * g.ldb + C) * 2u; }
    const size_t kstep = (size_t)(BK * 2);
    const size_t hstepA = (size_t)HALF * g.lda * 2, hstepB = (size_t)HALF * g.ldb * 2;
    const size_t tstepA = 2 * hstepA, tstepB = 2 * hstepB;
    const unsigned ldsw = (unsigned)wid * 1024u;
    const int aoff = lds_byte(wr * 64 + fr, fq * 8), boff = lds_byte(wc * 32 + fr, fq * 8);
#define PG8_SA(b, h) (((b) * 2 + (h)) * HTB)
#define PG8_SB(b, h) ((4 + (b) * 2 + (h)) * HTB)
#define PG8_STAGE(bufoff, gbase, voff) do { _Pragma("unroll") for (int _i = 0; _i < 2; ++_i) \
        __builtin_amdgcn_global_load_lds((const unsigned*)((const char*)(gbase) + (voff)[_i]), (LAS unsigned*)(lds + (bufoff) + ldsw + _i * 8192), 16, 0, 0); } while (0)
#define PG8_LDA(dst, b, h) do { _Pragma("unroll") for (int m = 0; m < 4; ++m) _Pragma("unroll") for (int k = 0; k < 2; ++k) dst[m][k] = *(const LAS bf16x8*)(lds + PG8_SA(b, h) + aoff + m * 2048 + k * 1024); } while (0)
#define PG8_LDB(dst, b, h) do { _Pragma("unroll") for (int n = 0; n < 2; ++n) _Pragma("unroll") for (int k = 0; k < 2; ++k) dst[n][k] = *(const LAS bf16x8*)(lds + PG8_SB(b, h) + boff + n * 2048 + k * 1024); } while (0)
#define PG8_MMA(ai, bj, At, Bt) do { __builtin_amdgcn_s_setprio(1); _Pragma("unroll") for (int m = 0; m < 4; ++m) _Pragma("unroll") for (int n = 0; n < 2; ++n) _Pragma("unroll") for (int k = 0; k < 2; ++k) \
        acc[ai][bj][m][n] = __builtin_amdgcn_mfma_f32_16x16x32_bf16(Bt[n][k], At[m][k], acc[ai][bj][m][n], 0, 0, 0); __builtin_amdgcn_s_setprio(0); } while (0)
#define PG8_WAIT_V(n) asm volatile("s_waitcnt vmcnt(" #n ")" ::: "memory")
#define PG8_WAIT_L(n) asm volatile("s_waitcnt lgkmcnt(" #n ")" ::: "memory")
#define PG8_BAR __builtin_amdgcn_s_barrier()
#define PG8_SCHED __builtin_amdgcn_sched_barrier(0)
    Unit cur, nxt; int ui = 0;
    if (!S.next(0, cur)) return;
    f32x4 acc[2][2][4][2];
#pragma unroll
    for (int a = 0; a < 2; ++a)
#pragma unroll
        for (int b = 0; b < 2; ++b)
#pragma unroll
            for (int m = 0; m < 4; ++m)
#pragma unroll
                for (int n = 0; n < 2; ++n) acc[a][b][m][n] = (f32x4){0.f, 0.f, 0.f, 0.f};
    bf16x8 At[4][2], B0[2][2], B1[2][2];
    const char* cA = (const char*)g.A + (size_t)cur.pm * tstepA; const char* cB = (const char*)g.Bt + (size_t)cur.pn * tstepB;
    PG8_STAGE(PG8_SB(0, 0), cB, voffB); PG8_STAGE(PG8_SB(0, 1), cB + hstepB, voffB); PG8_STAGE(PG8_SA(0, 0), cA, voffA); PG8_STAGE(PG8_SA(0, 1), cA + hstepA, voffA);
    if (wr == 1) PG8_BAR;
    PG8_WAIT_V(2); PG8_BAR;
    PG8_STAGE(PG8_SB(1, 0), cB + kstep, voffB); PG8_STAGE(PG8_SA(1, 0), cA + kstep, voffA); PG8_STAGE(PG8_SB(1, 1), cB + hstepB + kstep, voffB);
    PG8_WAIT_V(6); PG8_BAR;
    for (;;) {
        const bool has_next = S.next(ui + 1, nxt);
        const char* nA = has_next ? (const char*)g.A + (size_t)nxt.pm * tstepA : cA; const char* nB = has_next ? (const char*)g.Bt + (size_t)nxt.pn * tstepB : cB;
        for (int t = 0; t < nt; t += 2) {
            const bool last = (t == nt - 2);
            const char* a1 = cA + (size_t)(t + 1) * kstep;
            const char* a2 = last ? nA : cA + (size_t)(t + 2) * kstep; const char* b2 = last ? nB : cB + (size_t)(t + 2) * kstep;
            const char* a3 = a2 + kstep; const char* b3 = b2 + kstep;
            PG8_LDB(B0, 0, 0); PG8_LDB(B1, 0, 1); PG8_SCHED; PG8_LDA(At, 0, 0); PG8_STAGE(PG8_SA(1, 1), a1 + hstepA, voffA);
            PG8_WAIT_V(8); PG8_WAIT_L(0); PG8_BAR; PG8_MMA(0, 0, At, B0); PG8_MMA(0, 1, At, B1); PG8_BAR; PG8_SCHED;
            PG8_LDA(At, 0, 1); PG8_STAGE(PG8_SB(0, 0), b2, voffB); PG8_STAGE(PG8_SB(0, 1), b2 + hstepB, voffB); PG8_STAGE(PG8_SA(0, 0), a2, voffA);
            PG8_WAIT_V(8); PG8_WAIT_L(0); PG8_BAR; PG8_MMA(1, 0, At, B0); PG8_MMA(1, 1, At, B1); PG8_BAR; PG8_SCHED;
            PG8_LDB(B0, 1, 0); PG8_LDB(B1, 1, 1); PG8_SCHED; PG8_LDA(At, 1, 0); PG8_STAGE(PG8_SA(0, 1), a2 + hstepA, voffA);
            PG8_WAIT_V(8); PG8_WAIT_L(0); PG8_BAR; PG8_MMA(0, 0, At, B0); PG8_MMA(0, 1, At, B1); PG8_BAR; PG8_SCHED;
            PG8_LDA(At, 1, 1); PG8_STAGE(PG8_SB(1, 0), b3, voffB); PG8_STAGE(PG8_SB(1, 1), b3 + hstepB, voffB); PG8_STAGE(PG8_SA(1, 0), a3, voffA);
            PG8_WAIT_V(8); PG8_WAIT_L(0); PG8_BAR; PG8_MMA(1, 0, At, B0); PG8_MMA(1, 1, At, B1); PG8_BAR; PG8_SCHED;
            if constexpr (MID) { if (t + 2 == Epi::MID1 || t + 2 == Epi::MID2) { E.mid(acc, cur, (t + 2 == Epi::MID1) ? 0 : 1, wr, wc, fr, fq); PG8_SCHED; } }
        }
        if (wr == 0) PG8_BAR;
        E(acc, cur, wr, wc, fr, fq);
        if (!has_next) break;
#pragma unroll
        for (int a = 0; a < 2; ++a)
#pragma unroll
            for (int b = 0; b < 2; ++b)
#pragma unroll
                for (int m = 0; m < 4; ++m)
#pragma unroll
                    for (int n = 0; n < 2; ++n) acc[a][b][m][n] = (f32x4){0.f, 0.f, 0.f, 0.f};
        cur = nxt; cA = nA; cB = nB; ++ui;
        if (wr == 1) PG8_BAR;
    }
    PG8_WAIT_V(0);
    PG8_BAR;
#undef PG8_SA
#undef PG8_SB
#undef PG8_STAGE
#undef PG8_LDA
#undef PG8_LDB
#undef PG8_MMA
#undef PG8_WAIT_V
#undef PG8_WAIT_L
#undef PG8_BAR
#undef PG8_SCHED
}

__device__ __forceinline__ u32x4 pack8(f32x4 a, f32x4 b) { u32x4 w; w.x = cvt_pk_bf16(a[0], a[1]); w.y = cvt_pk_bf16(a[2], a[3]); w.z = cvt_pk_bf16(b[0], b[1]); w.w = cvt_pk_bf16(b[2], b[3]); return w; }
__device__ __forceinline__ f32x4 sig4(f32x4 v) { f32x4 r; r[0] = sigmoidf_fast(v[0]); r[1] = sigmoidf_fast(v[1]); r[2] = sigmoidf_fast(v[2]); r[3] = sigmoidf_fast(v[3]); return r; }
__device__ __forceinline__ f32x4 clamp4(f32x4 v, float lo, float hi) { f32x4 r; for (int i = 0; i < 4; ++i) r[i] = fminf(fmaxf(v[i], lo), hi); return r; }

struct EpiInProj {
    const float* bias;
    bf16_t *U, *CX, *SBb, *Q, *Kb, *VT, *SG;
    __device__ __forceinline__ void operator()(const f32x4 (&acc)[2][2][4][2], const Unit& u, int wr, int wc, int fr, int fq) const {
        const int t = u.pn, row0 = u.pm * BM + wr * 64 + fr, cw = wc * 32 + 8 * fq;
        f32x4 bv[2][2];
#define LOAD_BV() _Pragma("unroll") for (int bj = 0; bj < 2; ++bj) _Pragma("unroll") for (int n = 0; n < 2; ++n) bv[bj][n] = *(const f32x4*)(bias + t * BM + bj * HALF + cw + 4 * n)
        if (t < 12) {
            LOAD_BV();
            const bool glu = t < 6; bf16_t* O = (glu ? U : CX) + (glu ? t : t - 6) * HALF + cw;
#pragma unroll
            for (int ai = 0; ai < 2; ++ai)
#pragma unroll
                for (int m = 0; m < 4; ++m) {
                    const int row = row0 + ai * HALF + m * 16;
                    f32x4 a0 = acc[ai][0][m][0] + bv[0][0], a1 = acc[ai][0][m][1] + bv[0][1], g0 = acc[ai][1][m][0] + bv[1][0], g1 = acc[ai][1][m][1] + bv[1][1];
                    if (glu) { g0 = sig4(g0); g1 = sig4(g1); }
                    *(u32x4*)(O + (size_t)row * CW) = pack8(a0 * g0, a1 * g1);
                }
        } else if (t == 22) {
            LOAD_BV();
#pragma unroll
            for (int ai = 0; ai < 2; ++ai)
#pragma unroll
                for (int m = 0; m < 4; ++m) {
                    const int row = row0 + ai * HALF + m * 16;
#pragma unroll
                    for (int bj = 0; bj < 2; ++bj) {
                        const u32x4 w = pack8(acc[ai][bj][m][0] + bv[bj][0], acc[ai][bj][m][1] + bv[bj][1]);
                        bf16_t* o = VT + (size_t)(bj * HALF + cw) * S + row;
                        o[0 * (size_t)S] = (bf16_t)(w.x & 0xffffu); o[1 * (size_t)S] = (bf16_t)(w.x >> 16); o[2 * (size_t)S] = (bf16_t)(w.y & 0xffffu); o[3 * (size_t)S] = (bf16_t)(w.y >> 16);
                        o[4 * (size_t)S] = (bf16_t)(w.z & 0xffffu); o[5 * (size_t)S] = (bf16_t)(w.z >> 16); o[6 * (size_t)S] = (bf16_t)(w.w & 0xffffu); o[7 * (size_t)S] = (bf16_t)(w.w >> 16);
                    }
                }
        } else {
            bf16_t* O; int ld; float sc = 1.f; bool sg = false;
            if (t < 15) { O = SBb + (t - 12) * BM; ld = CW; }
            else if (t < 21) { O = Q + (t - 15) * BM; ld = AW; sc = QSCALE; }
            else if (t == 21) { O = Kb; ld = KVW; }
            else { O = SG + (t - 23) * BM; ld = NG; sg = true; }
            O += cw;
            LOAD_BV();
#pragma unroll
            for (int ai = 0; ai < 2; ++ai)
#pragma unroll
                for (int m = 0; m < 4; ++m) {
                    const int row = row0 + ai * HALF + m * 16;
#pragma unroll
                    for (int bj = 0; bj < 2; ++bj) {
                        f32x4 v0 = acc[ai][bj][m][0] + bv[bj][0], v1 = acc[ai][bj][m][1] + bv[bj][1];
                        if (sg) { v0 = sig4(clamp4(v0, -60.f, 60.f)); v1 = sig4(clamp4(v1, -60.f, 60.f)); } else { v0 = v0 * sc; v1 = v1 * sc; }
                        *(u32x4*)(O + (size_t)row * ld + bj * HALF) = pack8(v0, v1);
                    }
                }
        }
    }
};

__device__ __forceinline__ f32x4 up_lo(u32x2 p) { return (f32x4){bf_lo(p.x), bf_hi(p.x), bf_lo(p.y), bf_hi(p.y)}; }
__device__ __forceinline__ f32x4 rcp4(f32x4 v) { f32x4 r; for (int i = 0; i < 4; ++i) r[i] = __builtin_amdgcn_rcpf(v[i]); return r; }

struct EpiMerge {
    static constexpr int MID1 = CW / BK, MID2 = 2 * CW / BK;
    const bf16_t* SG; bf16_t* MG;
    __device__ __forceinline__ void mid(f32x4 (&acc)[2][2][4][2], const Unit& u, int which, int wr, int wc, int fr, int fq) const {
        const unsigned loff = (unsigned)(fr * NG + 8 * fq) * 2u;
        const char* nb = (const char*)SG + ((size_t)(u.pm * BM + wr * 64) * NG + (size_t)which * D + u.pn * BM + wc * 32) * 2;
#pragma unroll
        for (int ai = 0; ai < 2; ++ai)
#pragma unroll
            for (int bj = 0; bj < 2; ++bj) {
                u32x4 nv[4], dv[4];
#pragma unroll
                for (int m = 0; m < 4; ++m) { const char* p = nb + ((size_t)(ai * HALF + m * 16) * NG + bj * HALF) * 2; nv[m] = *(const u32x4*)(p + loff); dv[m] = *(const u32x4*)(p + (size_t)D * 2 + loff); }
#pragma unroll
                for (int m = 0; m < 4; ++m) {
                    const f32x4 r0 = up_lo((u32x2){nv[m].x, nv[m].y}) * rcp4(up_lo((u32x2){dv[m].x, dv[m].y}));
                    const f32x4 r1 = up_lo((u32x2){nv[m].z, nv[m].w}) * rcp4(up_lo((u32x2){dv[m].z, dv[m].w}));
                    acc[ai][bj][m][0] = acc[ai][bj][m][0] * r0; acc[ai][bj][m][1] = acc[ai][bj][m][1] * r1;
                }
                __builtin_amdgcn_sched_barrier(0);
            }
    }
    __device__ __forceinline__ void operator()(const f32x4 (&acc)[2][2][4][2], const Unit& u, int wr, int wc, int fr, int fq) const {
        const unsigned loff = (unsigned)(fr * NG + 8 * fq) * 2u, loffo = (unsigned)(fr * D + 8 * fq) * 2u;
        const char* gb = (const char*)SG + ((size_t)(u.pm * BM + wr * 64) * NG + (size_t)2 * D + u.pn * BM + wc * 32) * 2;
        char* ob = (char*)MG + ((size_t)(u.pm * BM + wr * 64) * D + u.pn * BM + wc * 32) * 2;
#pragma unroll
        for (int ai = 0; ai < 2; ++ai)
#pragma unroll
            for (int bj = 0; bj < 2; ++bj) {
                u32x4 gv[4];
#pragma unroll
                for (int m = 0; m < 4; ++m) gv[m] = *(const u32x4*)(gb + ((size_t)(ai * HALF + m * 16) * NG + bj * HALF) * 2 + loff);
#pragma unroll
                for (int m = 0; m < 4; ++m) {
                    const f32x4 v0 = acc[ai][bj][m][0] * up_lo((u32x2){gv[m].x, gv[m].y}), v1 = acc[ai][bj][m][1] * up_lo((u32x2){gv[m].z, gv[m].w});
                    *(u32x4*)(ob + ((size_t)(ai * HALF + m * 16) * D + bj * HALF) * 2 + loffo) = pack8(v0, v1);
                }
                __builtin_amdgcn_sched_barrier(0);
            }
    }
};

struct EpiResid {
    const float* R; const float* bias; float* O;
    __device__ __forceinline__ void operator()(const f32x4 (&acc)[2][2][4][2], const Unit& u, int wr, int wc, int fr, int fq) const {
        const int row0 = u.pm * BM + wr * 64 + fr, col0 = u.pn * BM + wc * 32 + 8 * fq;
        f32x4 bv[2][2];
#pragma unroll
        for (int bj = 0; bj < 2; ++bj)
#pragma unroll
            for (int n = 0; n < 2; ++n) bv[bj][n] = *(const f32x4*)(bias + col0 + bj * HALF + 4 * n);
#pragma unroll
        for (int ai = 0; ai < 2; ++ai) {
            f32x4 rv[4][2][2];
#pragma unroll
            for (int m = 0; m < 4; ++m)
#pragma unroll
                for (int bj = 0; bj < 2; ++bj)
#pragma unroll
                    for (int n = 0; n < 2; ++n) rv[m][bj][n] = *(const f32x4*)(R + (size_t)(row0 + ai * HALF + m * 16) * D + col0 + bj * HALF + 4 * n);
#pragma unroll
            for (int m = 0; m < 4; ++m)
#pragma unroll
                for (int bj = 0; bj < 2; ++bj)
#pragma unroll
                    for (int n = 0; n < 2; ++n) *(f32x4*)(O + (size_t)(row0 + ai * HALF + m * 16) * D + col0 + bj * HALF + 4 * n) = rv[m][bj][n] * ALPHA + acc[ai][bj][m][n] + bv[bj][n];
            __builtin_amdgcn_sched_barrier(0);
        }
    }
};

struct EpiRelu2 {
    const float* bias; bf16_t* O;
    __device__ __forceinline__ void operator()(const f32x4 (&acc)[2][2][4][2], const Unit& u, int wr, int wc, int fr, int fq) const {
        const int row0 = u.pm * BM + wr * 64 + fr, col0 = u.pn * BM + wc * 32 + 8 * fq;
        f32x4 bv[2][2];
#pragma unroll
        for (int bj = 0; bj < 2; ++bj)
#pragma unroll
            for (int n = 0; n < 2; ++n) bv[bj][n] = *(const f32x4*)(bias + col0 + bj * HALF + 4 * n);
#pragma unroll
        for (int ai = 0; ai < 2; ++ai)
#pragma unroll
            for (int m = 0; m < 4; ++m)
#pragma unroll
                for (int bj = 0; bj < 2; ++bj) {
                    f32x4 v0 = acc[ai][bj][m][0] + bv[bj][0], v1 = acc[ai][bj][m][1] + bv[bj][1];
#pragma unroll
                    for (int i = 0; i < 4; ++i) { v0[i] = fmaxf(v0[i], 0.f); v0[i] *= v0[i]; v1[i] = fmaxf(v1[i], 0.f); v1[i] *= v1[i]; }
                    *(u32x4*)(O + (size_t)(row0 + ai * HALF + m * 16) * FF + col0 + bj * HALF) = pack8(v0, v1);
                }
    }
};
}

__host__ __device__ __forceinline__ int inproj_dst_row(int o) {
    if (o < 768) return 256 * (o / 128) + (o % 128);
    if (o < 1536) { const int c = o - 768; return 256 * (c / 128) + 128 + (c % 128); }
    if (o < 2304) return 12 * 256 + (o - 1536);
    if (o < 3072) { const int c = o - 2304; return 256 * (6 + c / 128) + (c % 128); }
    if (o < 3840) { const int c = o - 3072; return 256 * (6 + c / 128) + 128 + (c % 128); }
    return o;
}

__device__ __forceinline__ void transpose_item(const float* __restrict__ W, int N, bf16_t* WT, int K, int k0, int n0, int dst_row, LAS float* scr, int lane) {
    const int kr = lane >> 3, nc = lane & 7;
    f32x4 v[8];
#pragma unroll
    for (int i = 0; i < 8; ++i) v[i] = *(const f32x4*)(W + (size_t)(k0 + 8 * i + kr) * N + n0 + 4 * nc);
#pragma unroll
    for (int i = 0; i < 8; ++i) { LAS float* s = scr + (8 * i + kr) * 33 + 4 * nc; s[0] = v[i][0]; s[1] = v[i][1]; s[2] = v[i][2]; s[3] = v[i][3]; }
    LDS_WAIT();
    const int c = lane & 7;
#pragma unroll
    for (int j = 0; j < 4; ++j) { const int n = (lane >> 3) + 8 * j; const LAS float* s = scr + (8 * c) * 33 + n;
        u32x4 o; o.x = cvt_pk_bf16(s[0 * 33], s[1 * 33]); o.y = cvt_pk_bf16(s[2 * 33], s[3 * 33]); o.z = cvt_pk_bf16(s[4 * 33], s[5 * 33]); o.w = cvt_pk_bf16(s[6 * 33], s[7 * 33]);
        *(u32x4*)(WT + (size_t)(dst_row + n) * K + k0 + 8 * c) = o; }
    LDS_WAIT();
}

struct LayerW { bf16_t *WinT, *WbT, *WoT, *W1T, *W2T; };
__device__ __forceinline__ LayerW layer_w(unsigned char* ws, int l) {
    unsigned char* b = ws + WS_W + (size_t)l * W_LAYER_B; LayerW w;
    w.WinT = (bf16_t*)b; w.WbT = (bf16_t*)(b + W_IN_B); w.WoT = (bf16_t*)(b + W_IN_B + W_B_B); w.W1T = (bf16_t*)(b + W_IN_B + W_B_B + W_O_B); w.W2T = (bf16_t*)(b + W_IN_B + W_B_B + W_O_B + W_1_B);
    return w;
}

__device__ __forceinline__ void convert_phase(const float* w_in, const float* w_br, const float* w_out, const float* w_1, const float* w_2, const float* b_in, const LayerW& W, float* biasP,
                                              LAS unsigned char* lds, int gw, int NGW, int wave, int lane, int gtid, int NGT) {
    LAS float* scr = (LAS float*)(lds + wave * 16384);
    constexpr int I_IN = (D / 64) * (NIN / 32), I_B = (MIXW / 64) * (D / 32), I_O = (D / 64) * (D / 32), I_1 = (D / 64) * (FF / 32), I_2 = (FF / 64) * (D / 32);
    constexpr int NITEMS = I_IN + I_B + I_O + I_1 + I_2;
    for (int it = gw; it < NITEMS; it += NGW) {
        int r = it;
        if (r < I_IN) { const int nb = r % (NIN / 32), kb = r / (NIN / 32); transpose_item(w_in, NIN, W.WinT, D, 64 * kb, 32 * nb, inproj_dst_row(32 * nb), scr, lane); continue; } r -= I_IN;
        if (r < I_B) { const int nb = r % (D / 32), kb = r / (D / 32); transpose_item(w_br, D, W.WbT, MIXW, 64 * kb, 32 * nb, 32 * nb, scr, lane); continue; } r -= I_B;
        if (r < I_O) { const int nb = r % (D / 32), kb = r / (D / 32); transpose_item(w_out, D, W.WoT, D, 64 * kb, 32 * nb, 32 * nb, scr, lane); continue; } r -= I_O;
        if (r < I_1) { const int nb = r % (FF / 32), kb = r / (FF / 32); transpose_item(w_1, FF, W.W1T, D, 64 * kb, 32 * nb, 32 * nb, scr, lane); continue; } r -= I_1;
        { const int nb = r % (D / 32), kb = r / (D / 32); transpose_item(w_2, D, W.W2T, FF, 64 * kb, 32 * nb, 32 * nb, scr, lane); }
    }
    for (int o = gtid; o < NIN; o += NGT) biasP[inproj_dst_row(o)] = b_in[o];
}

__device__ __forceinline__ void cvt_rows_phase(const float* X, bf16_t* XB, int gtid, int NGT) {
    for (size_t i = (size_t)gtid; i < (size_t)S * D / 8; i += (size_t)NGT) {
        const f32x4 a = *(const f32x4*)(X + i * 8), b = *(const f32x4*)(X + i * 8 + 4);
        *(u32x4*)(XB + i * 8) = pg8::pack8(a, b);
    }
}

__device__ __forceinline__ void ln_phase(const float* V, const float* g, const float* b, float* OF, bf16_t* OB, int gw, int NGW, int lane) {
    for (int row = gw; row < S; row += NGW) {
        const f32x4* vr = (const f32x4*)(V + (size_t)row * D) + lane;
        f32x4 v[16]; float s = 0.f;
#pragma unroll
        for (int j = 0; j < 16; ++j) { v[j] = vr[64 * j]; s += (v[j][0] + v[j][1]) + (v[j][2] + v[j][3]); }
        const float mean = wave_sum(s) * (1.f / D); float s2 = 0.f;
#pragma unroll
        for (int j = 0; j < 16; ++j) { v[j] = v[j] - mean; s2 += (v[j][0] * v[j][0] + v[j][1] * v[j][1]) + (v[j][2] * v[j][2] + v[j][3] * v[j][3]); }
        const float rstd = 1.f / sqrtf(wave_sum(s2) * (1.f / D) + LN_EPS);
        f32x4* of = (f32x4*)(OF + (size_t)row * D) + lane; u32x2* ob = (u32x2*)(OB + (size_t)row * D) + lane;
#pragma unroll
        for (int j = 0; j < 16; ++j) {
            const f32x4 gg = ((const f32x4*)g)[64 * j + lane], bb = ((const f32x4*)b)[64 * j + lane];
            const f32x4 y = v[j] * rstd * gg + bb;
            of[64 * j] = y; ob[64 * j] = (u32x2){cvt_pk_bf16(y[0], y[1]), cvt_pk_bf16(y[2], y[3])};
        }
    }
}

__device__ __forceinline__ void convB_phase(const bf16_t* CX, const bf16_t* SBb, const float* w3, bf16_t* Y, int gtid, int NGT) {
    for (int idx = gtid; idx < S * (CW / 8); idx += NGT) {
        const int t = idx / (CW / 8), c = (idx % (CW / 8)) * 8;
        const u32x4 z = (u32x4){0u, 0u, 0u, 0u};
        const u32x4 x2 = *(const u32x4*)(CX + (size_t)t * CW + c);
        const u32x4 x1 = t >= 1 ? *(const u32x4*)(CX + (size_t)(t - 1) * CW + c) : z;
        const u32x4 x0 = t >= 2 ? *(const u32x4*)(CX + (size_t)(t - 2) * CW + c) : z;
        const u32x4 sb = *(const u32x4*)(SBb + (size_t)t * CW + c);
        float o[8];
#pragma unroll
        for (int e = 0; e < 4; ++e) {
            const f32x2 w0 = *(const f32x2*)(w3 + 0 * CW + c + 2 * e), w1 = *(const f32x2*)(w3 + 1 * CW + c + 2 * e), w2 = *(const f32x2*)(w3 + 2 * CW + c + 2 * e);
            o[2 * e] = bf_lo(sb[e]) * (w0[0] * bf_lo(x0[e]) + w1[0] * bf_lo(x1[e]) + w2[0] * bf_lo(x2[e]));
            o[2 * e + 1] = bf_hi(sb[e]) * (w0[1] * bf_hi(x0[e]) + w1[1] * bf_hi(x1[e]) + w2[1] * bf_hi(x2[e]));
        }
        u32x4 w; w.x = cvt_pk_bf16(o[0], o[1]); w.y = cvt_pk_bf16(o[2], o[3]); w.z = cvt_pk_bf16(o[4], o[5]); w.w = cvt_pk_bf16(o[6], o[7]);
        *(u32x4*)(Y + (size_t)t * MIXW + CW + c) = w;
    }
}

__device__ __forceinline__ void convA_unit(const bf16_t* U, const float* w, const float* cb, const float* g, const float* b, bf16_t* Y, int r0, LAS unsigned char* lds, int tid, int wave, int lane) {
    for (int c = tid; c < 62 * 96; c += 512) { const int rr = c / 96, cc = c % 96, gr = r0 - 30 + rr;
        const u32x4 v = gr >= 0 ? *(const u32x4*)(U + (size_t)gr * CW + cc * 8) : (u32x4){0u, 0u, 0u, 0u};
        *(LAS u32x4*)(lds + rr * 1536 + cc * 16) = v; }
    __syncthreads();
    f32x2 acc[4][6], w0[6], w1[6], w2[6], w3[6];
#pragma unroll
    for (int j = 0; j < 6; ++j) { w1[j] = (f32x2){0.f, 0.f}; w2[j] = w1[j]; w3[j] = w1[j]; w0[j] = w1[j];
#pragma unroll
        for (int r = 0; r < 4; ++r) acc[r][j] = (f32x2){0.f, 0.f}; }
    const LAS unsigned char* lrow = lds + (4 * wave) * 1536 + lane * 4;
#pragma unroll 2
    for (int i = 0; i < 34; ++i) {
#pragma unroll
        for (int j = 0; j < 6; ++j) { w3[j] = w2[j]; w2[j] = w1[j]; w1[j] = w0[j]; w0[j] = (i <= 30) ? *(const f32x2*)(w + (size_t)(i <= 30 ? i : 30) * CW + 2 * lane + 128 * j) : (f32x2){0.f, 0.f}; }
#pragma unroll
        for (int j = 0; j < 6; ++j) {
            const unsigned p = *(const LAS unsigned*)(lrow + i * 1536 + j * 256);
            const f32x2 uu = (f32x2){bf_lo(p), bf_hi(p)};
            acc[0][j] += w0[j] * uu; acc[1][j] += w1[j] * uu; acc[2][j] += w2[j] * uu; acc[3][j] += w3[j] * uu;
        }
    }
#pragma unroll
    for (int r = 0; r < 4; ++r) {
        const int row = r0 + 4 * wave + r; float s = 0.f;
#pragma unroll
        for (int j = 0; j < 6; ++j) { acc[r][j] += *(const f32x2*)(cb + 2 * lane + 128 * j); s += acc[r][j][0] + acc[r][j][1]; }
        const float mean = wave_sum(s) * (1.f / CW); float s2 = 0.f;
#pragma unroll
        for (int j = 0; j < 6; ++j) { acc[r][j] = acc[r][j] - mean; s2 += acc[r][j][0] * acc[r][j][0] + acc[r][j][1] * acc[r][j][1]; }
        const float rstd = 1.f / sqrtf(wave_sum(s2) * (1.f / CW) + LN_EPS);
#pragma unroll
        for (int j = 0; j < 6; ++j) {
            const f32x2 gg = *(const f32x2*)(g + 2 * lane + 128 * j), bb = *(const f32x2*)(b + 2 * lane + 128 * j);
            f32x2 y = acc[r][j] * rstd * gg + bb; y[0] = y[0] * sigmoidf_fast(y[0]); y[1] = y[1] * sigmoidf_fast(y[1]);
            *(unsigned*)(Y + (size_t)row * MIXW + 2 * lane + 128 * j) = cvt_pk_bf16(y[0], y[1]);
        }
    }
    __syncthreads();
}

__device__ __forceinline__ void attn_item(const bf16_t* Q, const bf16_t* Kb, const bf16_t* VT, bf16_t* Y, const float* sinks, int qb, int h, int lane) {
    const int fr = lane & 15, fq = lane >> 4, kvh = h / 6, q0 = qb * 16, kstart = q0 - 144;
    const float slope = (h < 16) ? __builtin_amdgcn_exp2f(-0.5f * (float)(h + 1)) : __builtin_amdgcn_exp2f(-0.25f * (float)(2 * (h - 16) + 1));
    const float slope2 = slope * L2E, sink2 = sinks[h] * L2E;
    const bf16_t* qp = Q + (size_t)(q0 + fr) * AW + h * HD + fq * 8;
    const bf16x8 qf0 = *(const bf16x8*)qp, qf1 = *(const bf16x8*)(qp + 32);
    f32x4 s[10];
#pragma unroll
    for (int kt = 1; kt < 10; ++kt) {
        int key = kstart + kt * 16 + fr; key = key < 0 ? 0 : key;
        const bf16_t* kp = Kb + (size_t)key * KVW + kvh * HD + fq * 8;
        const bf16x8 k0 = *(const bf16x8*)kp, k1 = *(const bf16x8*)(kp + 32);
        f32x4 z = (f32x4){0.f, 0.f, 0.f, 0.f};
        z = __builtin_amdgcn_mfma_f32_16x16x32_bf16(k0, qf0, z, 0, 0, 0);
        z = __builtin_amdgcn_mfma_f32_16x16x32_bf16(k1, qf1, z, 0, 0, 0);
        s[kt] = z;
    }
    const int qpos = q0 + fr; float mx = sink2;
#pragma unroll
    for (int kt = 1; kt < 10; ++kt)
#pragma unroll
        for (int i = 0; i < 4; ++i) {
            const int key = kstart + kt * 16 + fq * 4 + i, dist = qpos - key;
            const bool valid = (dist >= 0) && (dist < 128) && (key >= 0);
            const float v = valid ? (s[kt][i] - slope2 * (float)dist) : -__builtin_inff();
            s[kt][i] = v; mx = fmaxf(mx, v);
        }
    mx = fmaxf(mx, __shfl_xor(mx, 16)); mx = fmaxf(mx, __shfl_xor(mx, 32));
    float sum = 0.f;
#pragma unroll
    for (int kt = 1; kt < 10; ++kt)
#pragma unroll
        for (int i = 0; i < 4; ++i) { const float p = __builtin_amdgcn_exp2f(s[kt][i] - mx); s[kt][i] = p; sum += p; }
    sum += __shfl_xor(sum, 16); sum += __shfl_xor(sum, 32);
    sum += __builtin_amdgcn_exp2f(sink2 - mx);
    const float inv = 1.f / sum;
    s[0] = (f32x4){0.f, 0.f, 0.f, 0.f};
    f32x4 o[4];
#pragma unroll
    for (int dt = 0; dt < 4; ++dt) o[dt] = (f32x4){0.f, 0.f, 0.f, 0.f};
#pragma unroll
    for (int c = 0; c < 5; ++c) {
        const u32x4 pw = pg8::pack8(s[2 * c], s[2 * c + 1]);
        const bf16x8 pf = __builtin_bit_cast(bf16x8, pw);
        int kg0 = kstart + 32 * c + fq * 4, kg1 = kg0 + 16; kg0 = kg0 < 0 ? 0 : kg0; kg1 = kg1 < 0 ? 0 : kg1;
#pragma unroll
        for (int dt = 0; dt < 4; ++dt) {
            const bf16_t* vp = VT + (size_t)(kvh * HD + dt * 16 + fr) * S;
            const u32x2 lo = *(const u32x2*)(vp + kg0), hi = *(const u32x2*)(vp + kg1);
            const bf16x8 vf = __builtin_bit_cast(bf16x8, (u32x4){lo.x, lo.y, hi.x, hi.y});
            o[dt] = __builtin_amdgcn_mfma_f32_16x16x32_bf16(vf, pf, o[dt], 0, 0, 0);
        }
    }
    bf16_t* yp = Y + (size_t)(q0 + fr) * MIXW + 2 * CW + h * HD + fq * 4;
#pragma unroll
    for (int dt = 0; dt < 4; ++dt) { const f32x4 v = o[dt] * inv; *(u32x2*)(yp + dt * 16) = (u32x2){cvt_pk_bf16(v[0], v[1]), cvt_pk_bf16(v[2], v[3])}; }
}

constexpr int NPH = 9, NPHASES = DEPTH * NPH;
struct Args { const float* in[20]; float* out; unsigned char* ws; int ph_lo, ph_hi, one, pad; };
typedef const __attribute__((address_space(4))) Args* CArgsP;
#ifndef PH_MASK
#define PH_MASK 0x1ff
#endif

#define PHASE_BEGIN() CArgsP p = ap; asm volatile("" : "+s"(p)); int tz = threadIdx.x; asm volatile("" : "+v"(tz)); \
    const int lane = tz & 63, wave = __builtin_amdgcn_readfirstlane(tz >> 6); unsigned char* ws = p->ws; (void)lane; (void)wave; (void)ws; \
    const int G = gridDim.x, bx = blockIdx.x, vcu = (G % 8 == 0) ? (bx % 8) * (G / 8) + bx / 8 : bx, NGW = G * 8, NGT = G * 512; (void)NGW; (void)NGT; (void)vcu
#define GW() (vcu * 8 + wave)
#define GTID() (vcu * 512 + tz)

__global__ void __launch_bounds__(512, 2) fwd(Args a_unused) {
    extern __shared__ __attribute__((aligned(16))) unsigned char lds_raw[];
    LAS unsigned char* lds = (LAS unsigned char*)lds_raw;
    const CArgsP ap = (CArgsP)__builtin_amdgcn_kernarg_segment_ptr();
    for (int u = threadIdx.x; u < (LDS_BYTES - RING_BYTES) / 4; u += 512) ((LAS unsigned*)(lds + RING_BYTES))[u] = 0u;
    __syncthreads();
    if (ap->one) (void)xcd_barrier_post((unsigned*)(ap->ws + WS_CTL) + CW_BAR, (volatile LAS unsigned*)(lds + MISC_OFF) + 8);
#define IN(k) (((PH_MASK >> ((k) % NPH)) & 1) && ap->ph_lo <= (k) && (k) < ap->ph_hi)
#define GRID_BAR(k) do { if (IN(k) && IN((k) + 1)) { XcdBarrier xb_; xb_.bar = (unsigned*)(ws + WS_CTL) + CW_BAR; xb_.x = xb_xcc_id(); xb_.st = (volatile LAS unsigned*)(lds + MISC_OFF) + 8; xcd_barrier(xb_); } } while (0)

    for (int l = 0; l < DEPTH; ++l) {
        const int pb = l * NPH;
        if (IN(pb + 0)) {
            PHASE_BEGIN();
            const LayerW W = layer_w(ws, l);
            convert_phase(p->in[1] + (size_t)l * D * NIN, p->in[9] + (size_t)l * MIXW * D, p->in[10] + (size_t)l * D * D, p->in[14] + (size_t)l * D * FF, p->in[16] + (size_t)l * FF * D,
                          p->in[2] + (size_t)l * NIN, W, (float*)(ws + WS_BIASP + (size_t)l * 131072), lds, GW(), NGW, wave, lane, GTID(), NGT);
            if (l == 0) cvt_rows_phase(p->in[0], (bf16_t*)(ws + WS_XB), GTID(), NGT);
            GRID_BAR(pb + 0);
        }
        if (IN(pb + 1)) {
            PHASE_BEGIN();
            const LayerW W = layer_w(ws, l);
            pg8::Gemm g{(const bf16_t*)(ws + WS_XB), W.WinT, D, D, D}; pg8::StaticOrder So; So.init(S, NIN, G, bx);
            pg8::EpiInProj E{(const float*)(ws + WS_BIASP + (size_t)l * 131072), (bf16_t*)(ws + WS_U), (bf16_t*)(ws + WS_CX), (bf16_t*)(ws + WS_SB), (bf16_t*)(ws + WS_Q), (bf16_t*)(ws + WS_K), (bf16_t*)(ws + WS_VT), (bf16_t*)(ws + WS_SG)};
            pg8::gemm_phase<pg8::EpiInProj, false>(lds, g, So, E, tz);
            GRID_BAR(pb + 1);
        }
        if (IN(pb + 2)) {
            PHASE_BEGIN();
            bf16_t* Yb = (bf16_t*)(ws + WS_Y);
            for (int un = vcu; un < S / 32; un += G)
                convA_unit((const bf16_t*)(ws + WS_U), p->in[3] + (size_t)l * 31 * CW, p->in[4] + (size_t)l * CW, p->in[5] + (size_t)l * CW, p->in[6] + (size_t)l * CW, Yb, un * 32, lds, tz, wave, lane);
            convB_phase((const bf16_t*)(ws + WS_CX), (const bf16_t*)(ws + WS_SB), p->in[7] + (size_t)l * 3 * CW, Yb, GTID(), NGT);
            for (int it = GW(); it < (S / 16) * NQH; it += NGW)
                attn_item((const bf16_t*)(ws + WS_Q), (const bf16_t*)(ws + WS_K), (const bf16_t*)(ws + WS_VT), Yb, p->in[8] + (size_t)l * NQH, it % (S / 16), it / (S / 16), lane);
            GRID_BAR(pb + 2);
        }
        if (IN(pb + 3)) {
            PHASE_BEGIN();
            const LayerW W = layer_w(ws, l);
            pg8::Gemm g{(const bf16_t*)(ws + WS_Y), W.WbT, MIXW, MIXW, MIXW}; pg8::StaticOrder So; So.init(S, D, G, bx);
            pg8::EpiMerge E{(const bf16_t*)(ws + WS_SG), (bf16_t*)(ws + WS_MG)};
            pg8::gemm_phase<pg8::EpiMerge, true>(lds, g, So, E, tz);
            GRID_BAR(pb + 3);
        }
        if (IN(pb + 4)) {
            PHASE_BEGIN();
            const LayerW W = layer_w(ws, l);
            pg8::Gemm g{(const bf16_t*)(ws + WS_MG), W.WoT, D, D, D}; pg8::StaticOrder So; So.init(S, D, G, bx);
            pg8::EpiResid E{l == 0 ? p->in[0] : (const float*)(ws + WS_XF), p->in[11] + (size_t)l * D, (float*)(ws + WS_V)};
            pg8::gemm_phase<pg8::EpiResid, false>(lds, g, So, E, tz);
            GRID_BAR(pb + 4);
        }
        if (IN(pb + 5)) {
            PHASE_BEGIN();
            ln_phase((const float*)(ws + WS_V), p->in[12] + (size_t)l * D, p->in[13] + (size_t)l * D, (float*)(ws + WS_X1F), (bf16_t*)(ws + WS_X1B), GW(), NGW, lane);
            GRID_BAR(pb + 5);
        }
        if (IN(pb + 6)) {
            PHASE_BEGIN();
            const LayerW W = layer_w(ws, l);
            pg8::Gemm g{(const bf16_t*)(ws + WS_X1B), W.W1T, D, D, D}; pg8::StaticOrder So; So.init(S, FF, G, bx);
            pg8::EpiRelu2 E{p->in[15] + (size_t)l * FF, (bf16_t*)(ws + WS_HID)};
            pg8::gemm_phase<pg8::EpiRelu2, false>(lds, g, So, E, tz);
            GRID_BAR(pb + 6);
        }
        if (IN(pb + 7)) {
            PHASE_BEGIN();
            const LayerW W = layer_w(ws, l);
            pg8::Gemm g{(const bf16_t*)(ws + WS_HID), W.W2T, FF, FF, FF}; pg8::StaticOrder So; So.init(S, D, G, bx);
            pg8::EpiResid E{(const float*)(ws + WS_X1F), p->in[17] + (size_t)l * D, (float*)(ws + WS_V)};
            pg8::gemm_phase<pg8::EpiResid, false>(lds, g, So, E, tz);
            GRID_BAR(pb + 7);
        }
        if (IN(pb + 8)) {
            PHASE_BEGIN();
            ln_phase((const float*)(ws + WS_V), p->in[18] + (size_t)l * D, p->in[19] + (size_t)l * D, l == DEPTH - 1 ? p->out : (float*)(ws + WS_XF), (bf16_t*)(ws + WS_XB), GW(), NGW, lane);
            GRID_BAR(pb + 8);
        }
    }
#undef IN
#undef GRID_BAR
}

extern "C" void kernel_launch(void* const* d_in, const int* in_sizes, int n_in, void* d_out, int out_size, void* d_ws, size_t ws_size, hipStream_t stream) {
    static int grid = 0;
    if (grid == 0) {
        if (n_in != 20 || in_sizes[0] != S * D || out_size != S * D || ws_size < WS_END) {
            fprintf(stderr, "kernel_launch: unexpected shapes (n_in %d, in0 %d, out %d, ws %zu, need %zu); nothing launched\n", n_in, n_in > 0 ? in_sizes[0] : -1, out_size, ws_size, (size_t)WS_END); grid = -1; return; }
        int dev = 0, cus = 0, per_cu = 0;
        if (hipGetDevice(&dev) != hipSuccess || hipDeviceGetAttribute(&cus, hipDeviceAttributeMultiprocessorCount, dev) != hipSuccess) { grid = -1; return; }
        if (hipFuncSetAttribute((const void*)fwd, hipFuncAttributeMaxDynamicSharedMemorySize, LDS_BYTES) != hipSuccess) { fprintf(stderr, "kernel_launch: hipFuncSetAttribute failed\n"); grid = -1; return; }
        if (hipOccupancyMaxActiveBlocksPerMultiprocessor(&per_cu, (const void*)fwd, 512, LDS_BYTES) != hipSuccess || per_cu < 1) fprintf(stderr, "kernel_launch: occupancy query reports %d\n", per_cu);
        (void)hipGetLastError();
        grid = cus;
    }
    if (grid < 0) return;
    (void)hipMemsetAsync((char*)d_ws + WS_CTL, 0, CTL_ZERO_BYTES, stream);
    Args a{};
    for (int i = 0; i < 20; ++i) a.in[i] = (const float*)d_in[i];
    a.out = (float*)d_out; a.ws = (unsigned char*)d_ws; a.pad = 0;
#if MK_ONE_LAUNCH
    a.ph_lo = 0; a.ph_hi = NPHASES; a.one = 1;
    hipLaunchKernelGGL(fwd, dim3(grid), dim3(512), LDS_BYTES, stream, a);
#else
    a.one = 0;
    for (int p = 0; p < NPHASES; ++p) { a.ph_lo = p; a.ph_hi = p + 1; hipLaunchKernelGGL(fwd, dim3(grid), dim3(512), LDS_BYTES, stream, a); }
#endif
}
```

```cpp
#include <hip/hip_runtime.h>
#include <cstdio>
#include <cstdint>

#ifndef MK_ONE_LAUNCH
#define MK_ONE_LAUNCH 1
#endif

#define GAS __attribute__((address_space(1)))
#define LAS __attribute__((address_space(3)))
typedef unsigned short bf16_t;
typedef short bf16x8 __attribute__((ext_vector_type(8)));
typedef float f32x4 __attribute__((ext_vector_type(4)));
typedef float f32x2 __attribute__((ext_vector_type(2)));
typedef unsigned u32x4 __attribute__((ext_vector_type(4)));
typedef unsigned u32x2 __attribute__((ext_vector_type(2)));
typedef int i32x8 __attribute__((ext_vector_type(8)));
typedef int i32x4 __attribute__((ext_vector_type(4)));

constexpr int S = 8192, D = 4096, DEPTH = 4, CW = 768, AW = 1536, KVW = 256, NIN = 18176, FF = 16384, MIXW = 3072, NG = 3 * D;
constexpr int NQH = 24, HD = 64;
constexpr float LN_EPS = 1e-5f;
constexpr float ALPHA = 1.681792830507429f;
constexpr float L2E = 1.4426950408889634f;
constexpr float QSCALE = 0.125f * L2E;
constexpr int NBF = 5888;
constexpr float XQ_SCALE = 16.f, WQ_SCALE = 1024.f, GQ_DESCALE = 1.f / (16.f * 1024.f);

constexpr size_t MiB = 1u << 20;
constexpr size_t WS_CTL = 0, CTL_ZERO_BYTES = 1 * MiB;
constexpr size_t WS_BIASP = 1 * MiB;
constexpr size_t WS_XB = 2 * MiB;
constexpr size_t WS_X1B = WS_XB + 64 * MiB;
constexpr size_t WS_XF = WS_X1B + 64 * MiB;
constexpr size_t WS_X1F = WS_XF + 128 * MiB;
constexpr size_t WS_V = WS_X1F + 128 * MiB;
constexpr size_t WS_U = WS_V + 128 * MiB;
constexpr size_t WS_CX = WS_U + 12 * MiB;
constexpr size_t WS_SB = WS_CX + 12 * MiB;
constexpr size_t WS_Q = WS_SB + 12 * MiB;
constexpr size_t WS_K = WS_Q + 24 * MiB;
constexpr size_t WS_VT = WS_K + 4 * MiB;
constexpr size_t WS_SG = WS_VT + 4 * MiB;
constexpr size_t WS_Y = WS_SG + 192 * MiB;
constexpr size_t WS_MG = WS_Y + 48 * MiB;
constexpr size_t WS_HID = WS_MG + 64 * MiB;
constexpr size_t WS_W = WS_HID + 256 * MiB;
constexpr size_t W_IN_B = (size_t)NIN * D * 2, W_B_B = (size_t)D * MIXW * 2, W_O_B = (size_t)D * D * 2, W_1_B = (size_t)FF * D * 2, W_2_B = (size_t)D * FF * 2;
constexpr size_t W_LAYER_B = W_IN_B + W_B_B + W_O_B + W_1_B + W_2_B;
constexpr size_t WS_WG = WS_W + DEPTH * W_LAYER_B;
constexpr size_t W_G_B = (size_t)NG * D;
constexpr size_t WS_XQ = WS_WG + DEPTH * W_G_B;
constexpr size_t WS_END = WS_XQ + (size_t)S * D;
constexpr int CW_BAR = 4096;

constexpr int RING_BYTES = 131072;
constexpr int MISC_OFF = RING_BYTES + 320;
constexpr int LDS_BYTES = 147456;

#define LDS_WAIT() asm volatile("s_waitcnt lgkmcnt(0)" ::: "memory")
#define VM_WAIT() asm volatile("s_waitcnt vmcnt(0)" ::: "memory")

typedef __bf16 bf16x2_t __attribute__((ext_vector_type(2)));
__device__ __forceinline__ unsigned cvt_pk_bf16(float lo, float hi) { const f32x2 v = {lo, hi}; const bf16x2_t b = __builtin_convertvector(v, bf16x2_t); return __builtin_bit_cast(unsigned, b); }
__device__ __forceinline__ float bf_lo(unsigned u) { return __builtin_bit_cast(float, u << 16); }
__device__ __forceinline__ float bf_hi(unsigned u) { return __builtin_bit_cast(float, u & 0xffff0000u); }
__device__ __forceinline__ float sigmoidf_fast(float x) { return __builtin_amdgcn_rcpf(1.f + __builtin_amdgcn_exp2f(-L2E * x)); }
__device__ __forceinline__ float wave_sum(float v) {
#pragma unroll
    for (int o = 1; o < 64; o <<= 1) v += __shfl_xor(v, o);
    return v;
}

#define XB_TMO      128
#define XB_XCNT(j)  (256  + 64 * (j))
#define XB_XSUB(j)  (1280 + 64 * (j))
#define XB_XGEN(j)  (2304 + 64 * (j))
#define XB_TOP      3328
#define XB_TOPGEN   3392
#define XCD_BAR_WORDS 3456
#define XB_SPIN_CAP (1u << 20)

__device__ __forceinline__ unsigned xb_ld(unsigned* p)              { return __hip_atomic_load(p, __ATOMIC_RELAXED, __HIP_MEMORY_SCOPE_AGENT); }
__device__ __forceinline__ unsigned xb_add(unsigned* p, unsigned v) { return __hip_atomic_fetch_add(p, v, __ATOMIC_RELAXED, __HIP_MEMORY_SCOPE_AGENT); }
__device__ __forceinline__ unsigned xb_xcc_id() { return (unsigned)__builtin_amdgcn_s_getreg((3 << 11) | 20) & 0xFu; }
#define XB_SPIN(cond, bar) do { unsigned _sp = 0; while (cond) { __builtin_amdgcn_s_sleep(1); \
    if ((++_sp & 255u) == 0u) { if (xb_ld(&(bar)[XB_TMO])) break; if (_sp > XB_SPIN_CAP) { atomicAdd(&(bar)[XB_TMO], 1u); break; } } } } while (0)

struct XcdBarrier { unsigned* bar; unsigned x; volatile LAS unsigned* st; };

__device__ __forceinline__ XcdBarrier xcd_barrier_post(unsigned* bar, volatile LAS unsigned* st) {
    XcdBarrier b; b.bar = bar; b.x = xb_xcc_id(); b.st = st;
    if (threadIdx.x == 0) (void)xb_add(&bar[XB_XCNT(b.x)], 1u);
    return b;
}
__device__ __forceinline__ void xcd_barrier_complete(unsigned* bar, unsigned x, unsigned& nloc, unsigned& nx) {
    const unsigned G = gridDim.x * gridDim.y * gridDim.z;
    unsigned sum, cnt, mine, sp = 0u;
    for (;;) {
        sum = 0u; cnt = 0u; mine = 0u;
#pragma unroll
        for (unsigned j = 0; j < 16; ++j) { const unsigned c = xb_ld(&bar[XB_XCNT(j)]); sum += c; cnt += (c > 0u) ? 1u : 0u; mine = (j == x) ? c : mine; }
        if (sum == G) break;
        __builtin_amdgcn_s_sleep(1);
        if ((++sp & 255u) == 0u) { if (xb_ld(&bar[XB_TMO])) break; if (sp > XB_SPIN_CAP) { atomicAdd(&bar[XB_TMO], 1u); break; } }
    }
    nloc = mine > 0u ? mine : 1u; nx = cnt > 0u ? cnt : 1u;
}
__device__ __forceinline__ void xcd_barrier(const XcdBarrier& b) {
    asm volatile("s_waitcnt vmcnt(0)" ::: "memory");
    __syncthreads();
    if (threadIdx.x == 0) {
        unsigned* bar = b.bar;
        __builtin_amdgcn_s_waitcnt(0);
        unsigned nloc = b.st[0], nx = b.st[1];
        if (nloc == 0u) { xcd_barrier_complete(bar, b.x, nloc, nx); b.st[0] = nloc; b.st[1] = nx; }
        const unsigned old = xb_add(&bar[XB_XSUB(b.x)], 1u);
        const unsigned gen = old / nloc;
        if (old + 1u == (gen + 1u) * nloc) {
            __builtin_amdgcn_fence(__ATOMIC_RELEASE, "agent");
            asm volatile("s_waitcnt vmcnt(0)" ::: "memory");
            const unsigned og = xb_add(&bar[XB_TOP], 1u);
            const unsigned tg = og / nx;
            if (og + 1u == (tg + 1u) * nx) xb_add(&bar[XB_TOPGEN], 1u);
            else XB_SPIN(xb_ld(&bar[XB_TOPGEN]) == tg, bar);
            __builtin_amdgcn_fence(__ATOMIC_ACQUIRE, "agent");
            xb_add(&bar[XB_XGEN(b.x)], 1u);
            asm volatile("s_waitcnt vmcnt(0)" ::: "memory");
        } else {
            XB_SPIN(xb_ld(&bar[XB_XGEN(b.x)]) == gen, bar);
            __builtin_amdgcn_fence(__ATOMIC_ACQUIRE, "agent");
            asm volatile("s_waitcnt vmcnt(0)" ::: "memory");
        }
    }
    __syncthreads();
}

namespace pg8 {
constexpr int BM = 256, BK = 64, HALF = 128, HTB = HALF * BK * 2, NXCD = 8, WGM = 8;
__host__ __device__ __forceinline__ int lds_byte(int r, int c) { const int st = (r >> 4) * 2 + (c >> 5), rr = r & 15, cc = c & 31, ob = rr * 64 + cc * 2; return st * 1024 + (ob ^ (((ob >> 9) & 1) << 5)); }
__host__ __device__ __forceinline__ void stage_rc(int b, int& R, int& C) { const int st = b / 1024, sb = b % 1024, swz = sb ^ (((sb >> 9) & 1) << 5); R = (st >> 1) * 16 + swz / 64; C = (st & 1) * 32 + (swz % 64) / 2; }
__host__ __device__ __forceinline__ int perm32(int rho) { const int n = rho >> 4, i = rho & 15; return 8 * (i >> 2) + 4 * n + (i & 3); }

struct Unit { int pm, pn; };
struct Gemm { const void* A; const void* Bt; int ldaB, ldbB, nt; };

struct StaticOrder {
    int nM, nN, nwg, G, c;
    __device__ void init(int M, int N, int G_, int c_) { nM = M / BM; nN = N / BM; nwg = nM * nN; G = G_; c = c_; }
    __device__ bool next(int i, Unit& u) const {
        const long L = (long)i * G + c; if (L >= nwg) return false;
        int wgid = (int)L; { const int q = nwg / NXCD, r = nwg % NXCD, xcd = wgid % NXCD, off = wgid / NXCD; wgid = (xcd < r ? xcd * (q + 1) : r * (q + 1) + (xcd - r) * q) + off; }
        const int nig = WGM * nN, gid = wgid / nig, fm = gid * WGM, gsz = (nM - fm) < WGM ? (nM - fm) : WGM;
        u.pm = fm + ((wgid % nig) % gsz); u.pn = (wgid % nig) / gsz; return true;
    }
};

template <class Epi, bool MID, bool FP8 = false>
__device__ __forceinline__ void gemm_phase(LAS unsigned char* lds, const Gemm g, const StaticOrder& S, const Epi& E, const int tid) {
    const int wid = __builtin_amdgcn_readfirstlane(tid >> 6), lane = tid & 63, wr = wid >> 2, wc = wid & 3, fr = lane & 15, fq = lane >> 4;
    const int nt = g.nt;
    unsigned voffA, voffB;
    { int R, C; stage_rc(tid * 16, R, C); const int Rb = (R & ~31) + perm32(R & 31); voffA = (unsigned)(R * g.ldaB + C * 2); voffB = (unsigned)(Rb * g.ldbB + C * 2); }
    const size_t p2A = (size_t)64 * g.ldaB, p2B = (size_t)64 * g.ldbB;
    const size_t kstep = (size_t)(BK * 2);
    const size_t hstepA = (size_t)HALF * g.ldaB, hstepB = (size_t)HALF * g.ldbB;
    const size_t tstepA = 2 * hstepA, tstepB = 2 * hstepB;
    const unsigned ldsw = (unsigned)wid * 1024u;
    constexpr int KOFF = FP8 ? 16 : 1024;
    const int aoff = lds_byte(wr * 64 + fr, FP8 ? fq * 16 : fq * 8), boff = lds_byte(wc * 32 + fr, FP8 ? fq * 16 : fq * 8);
#define PG8_SA(b, h) (((b) * 2 + (h)) * HTB)
#define PG8_SB(b, h) ((4 + (b) * 2 + (h)) * HTB)
#define PG8_STAGE(bufoff, gbase, X) do { _Pragma("unroll") for (int _i = 0; _i < 2; ++_i) \
        __builtin_amdgcn_global_load_lds((const unsigned*)((const char*)(gbase) + (_i ? p2##X : (size_t)0) + voff##X), (LAS unsigned*)(lds + (bufoff) + ldsw + _i * 8192), 16, 0, 0); } while (0)
#define PG8_LD32(p) __builtin_shufflevector(*(const LAS i32x4*)(p), *(const LAS i32x4*)((p) + 16), 0, 1, 2, 3, 4, 5, 6, 7)
#define PG8_LDA(dst, b, h) do { _Pragma("unroll") for (int m = 0; m < 4; ++m) { if constexpr (FP8) dst##8[m] = PG8_LD32(lds + PG8_SA(b, h) + aoff + m * 2048); else { _Pragma("unroll") for (int k = 0; k < 2; ++k) dst[m][k] = *(const LAS bf16x8*)(lds + PG8_SA(b, h) + aoff + m * 2048 + k * KOFF); } } } while (0)
#define PG8_LDB(dst, b, h) do { _Pragma("unroll") for (int n = 0; n < 2; ++n) { if constexpr (FP8) dst##8[n] = PG8_LD32(lds + PG8_SB(b, h) + boff + n * 2048); else { _Pragma("unroll") for (int k = 0; k < 2; ++k) dst[n][k] = *(const LAS bf16x8*)(lds + PG8_SB(b, h) + boff + n * 2048 + k * KOFF); } } } while (0)
#define PG8_CAT8(x) __builtin_shufflevector(__builtin_bit_cast(i32x4, (x)[0]), __builtin_bit_cast(i32x4, (x)[1]), 0, 1, 2, 3, 4, 5, 6, 7)
#define PG8_MMA(ai, bj, At, Bt) do { __builtin_amdgcn_s_setprio(1); _Pragma("unroll") for (int m = 0; m < 4; ++m) _Pragma("unroll") for (int n = 0; n < 2; ++n) { \
        if constexpr (FP8) asm volatile("v_mfma_scale_f32_16x16x128_f8f6f4 %0, %1, %2, %0, %3, %3 op_sel_hi:[0,0,0]" : "+v"(acc[ai][bj][m][n]) : "v"(Bt##8[n]), "v"(At##8[m]), "v"(sc127)); \
        else { _Pragma("unroll") for (int k = 0; k < 2; ++k) acc[ai][bj][m][n] = __builtin_amdgcn_mfma_f32_16x16x32_bf16(Bt[n][k], At[m][k], acc[ai][bj][m][n], 0, 0, 0); } } \
        __builtin_amdgcn_s_setprio(0); } while (0)
#define PG8_WAIT_V(n) asm volatile("s_waitcnt vmcnt(" #n ")" ::: "memory")
#define PG8_WAIT_L(n) asm volatile("s_waitcnt lgkmcnt(" #n ")" ::: "memory")
#define PG8_BAR __builtin_amdgcn_s_barrier()
#define PG8_SCHED __builtin_amdgcn_sched_barrier(0)
    Unit cur, nxt; int ui = 0;
    if (!S.next(0, cur)) return;
    f32x4 acc[2][2][4][2];
#pragma unroll
    for (int a = 0; a < 2; ++a)
#pragma unroll
        for (int b = 0; b < 2; ++b)
#pragma unroll
            for (int m = 0; m < 4; ++m)
#pragma unroll
                for (int n = 0; n < 2; ++n) acc[a][b][m][n] = (f32x4){0.f, 0.f, 0.f, 0.f};
    int sc127 = 127; asm volatile("" : "+v"(sc127));
    bf16x8 At[4][2], B0[2][2], B1[2][2]; i32x8 At8[4], B08[2], B18[2]; (void)At; (void)B0; (void)B1; (void)At8; (void)B08; (void)B18;
    const char* cA = (const char*)g.A + (size_t)cur.pm * tstepA; const char* cB = (const char*)g.Bt + (size_t)cur.pn * tstepB;
    PG8_STAGE(PG8_SB(0, 0), cB, B); PG8_STAGE(PG8_SB(0, 1), cB + hstepB, B); PG8_STAGE(PG8_SA(0, 0), cA, A); PG8_STAGE(PG8_SA(0, 1), cA + hstepA, A);
    if (wr == 1) PG8_BAR;
    PG8_WAIT_V(2); PG8_BAR;
    PG8_STAGE(PG8_SB(1, 0), cB + kstep, B); PG8_STAGE(PG8_SA(1, 0), cA + kstep, A); PG8_STAGE(PG8_SB(1, 1), cB + hstepB + kstep, B);
    PG8_WAIT_V(6); PG8_BAR;
    for (;;) {
        const bool has_next = S.next(ui + 1, nxt);
        const char* nA = has_next ? (const char*)g.A + (size_t)nxt.pm * tstepA : cA; const char* nB = has_next ? (const char*)g.Bt + (size_t)nxt.pn * tstepB : cB;
        for (int t = 0; t < nt; t += 2) {
            const bool last = (t == nt - 2);
            const char* a1 = cA + (size_t)(t + 1) * kstep;
            const char* a2 = last ? nA : cA + (size_t)(t + 2) * kstep; const char* b2 = last ? nB : cB + (size_t)(t + 2) * kstep;
            const char* a3 = a2 + kstep; const char* b3 = b2 + kstep;
            PG8_LDB(B0, 0, 0); PG8_LDB(B1, 0, 1); PG8_SCHED; PG8_LDA(At, 0, 0); PG8_STAGE(PG8_SA(1, 1), a1 + hstepA, A);
            PG8_WAIT_V(8); PG8_WAIT_L(0); PG8_BAR; PG8_MMA(0, 0, At, B0); PG8_MMA(0, 1, At, B1); PG8_BAR; PG8_SCHED;
            PG8_LDA(At, 0, 1); PG8_STAGE(PG8_SB(0, 0), b2, B); PG8_STAGE(PG8_SB(0, 1), b2 + hstepB, B); PG8_STAGE(PG8_SA(0, 0), a2, A);
            PG8_WAIT_V(8); PG8_WAIT_L(0); PG8_BAR; PG8_MMA(1, 0, At, B0); PG8_MMA(1, 1, At, B1); PG8_BAR; PG8_SCHED;
            PG8_LDB(B0, 1, 0); PG8_LDB(B1, 1, 1); PG8_SCHED; PG8_LDA(At, 1, 0); PG8_STAGE(PG8_SA(0, 1), a2 + hstepA, A);
            PG8_WAIT_V(8); PG8_WAIT_L(0); PG8_BAR; PG8_MMA(0, 0, At, B0); PG8_MMA(0, 1, At, B1); PG8_BAR; PG8_SCHED;
            PG8_LDA(At, 1, 1); PG8_STAGE(PG8_SB(1, 0), b3, B); PG8_STAGE(PG8_SB(1, 1), b3 + hstepB, B); PG8_STAGE(PG8_SA(1, 0), a3, A);
            PG8_WAIT_V(8); PG8_WAIT_L(0); PG8_BAR; PG8_MMA(1, 0, At, B0); PG8_MMA(1, 1, At, B1); PG8_BAR; PG8_SCHED;
            if constexpr (MID) { if (t + 2 == Epi::MID1 || t + 2 == Epi::MID2) { E.mid(acc, cur, (t + 2 == Epi::MID1) ? 0 : 1, wr, wc, fr, fq); PG8_SCHED; } }
        }
        if (wr == 0) PG8_BAR;
        if constexpr (FP8) asm volatile("s_nop 15\n\ts_nop 15" ::: "memory");
        E(acc, cur, wr, wc, fr, fq);
        if (!has_next) break;
#pragma unroll
        for (int a = 0; a < 2; ++a)
#pragma unroll
            for (int b = 0; b < 2; ++b)
#pragma unroll
                for (int m = 0; m < 4; ++m)
#pragma unroll
                    for (int n = 0; n < 2; ++n) acc[a][b][m][n] = (f32x4){0.f, 0.f, 0.f, 0.f};
        cur = nxt; cA = nA; cB = nB; ++ui;
        if (wr == 1) PG8_BAR;
    }
    PG8_WAIT_V(0);
    PG8_BAR;
#undef PG8_SA
#undef PG8_SB
#undef PG8_STAGE
#undef PG8_LDA
#undef PG8_LD32
#undef PG8_LDB
#undef PG8_MMA
#undef PG8_CAT8
#undef PG8_WAIT_V
#undef PG8_WAIT_L
#undef PG8_BAR
#undef PG8_SCHED
}

__device__ __forceinline__ u32x4 pack8(f32x4 a, f32x4 b) { u32x4 w; w.x = cvt_pk_bf16(a[0], a[1]); w.y = cvt_pk_bf16(a[2], a[3]); w.z = cvt_pk_bf16(b[0], b[1]); w.w = cvt_pk_bf16(b[2], b[3]); return w; }
__device__ __forceinline__ f32x4 sig4(f32x4 v) { f32x4 r; r[0] = sigmoidf_fast(v[0]); r[1] = sigmoidf_fast(v[1]); r[2] = sigmoidf_fast(v[2]); r[3] = sigmoidf_fast(v[3]); return r; }
__device__ __forceinline__ f32x4 clamp4(f32x4 v, float lo, float hi) { f32x4 r; for (int i = 0; i < 4; ++i) r[i] = fminf(fmaxf(v[i], lo), hi); return r; }

struct EpiInProj {
    const float* bias;
    bf16_t *U, *CX, *SBb, *Q, *Kb, *VT, *SG;
    __device__ __forceinline__ void operator()(const f32x4 (&acc)[2][2][4][2], const Unit& u, int wr, int wc, int fr, int fq) const {
        const int t = u.pn, row0 = u.pm * BM + wr * 64 + fr, cw = wc * 32 + 8 * fq;
        f32x4 bv[2][2];
#define LOAD_BV() _Pragma("unroll") for (int bj = 0; bj < 2; ++bj) _Pragma("unroll") for (int n = 0; n < 2; ++n) bv[bj][n] = *(const f32x4*)(bias + t * BM + bj * HALF + cw + 4 * n)
        if (t < 12) {
            LOAD_BV();
            const bool glu = t < 6; bf16_t* O = (glu ? U : CX) + (glu ? t : t - 6) * HALF + cw;
#pragma unroll
            for (int ai = 0; ai < 2; ++ai)
#pragma unroll
                for (int m = 0; m < 4; ++m) {
                    const int row = row0 + ai * HALF + m * 16;
                    f32x4 a0 = acc[ai][0][m][0] + bv[0][0], a1 = acc[ai][0][m][1] + bv[0][1], g0 = acc[ai][1][m][0] + bv[1][0], g1 = acc[ai][1][m][1] + bv[1][1];
                    if (glu) { g0 = sig4(g0); g1 = sig4(g1); }
                    *(u32x4*)(O + (size_t)row * CW) = pack8(a0 * g0, a1 * g1);
                }
        } else if (t == 22) {
            LOAD_BV();
#pragma unroll
            for (int ai = 0; ai < 2; ++ai)
#pragma unroll
                for (int m = 0; m < 4; ++m) {
                    const int row = row0 + ai * HALF + m * 16;
#pragma unroll
                    for (int bj = 0; bj < 2; ++bj) {
                        const u32x4 w = pack8(acc[ai][bj][m][0] + bv[bj][0], acc[ai][bj][m][1] + bv[bj][1]);
                        bf16_t* o = VT + (size_t)(bj * HALF + cw) * S + row;
                        o[0 * (size_t)S] = (bf16_t)(w.x & 0xffffu); o[1 * (size_t)S] = (bf16_t)(w.x >> 16); o[2 * (size_t)S] = (bf16_t)(w.y & 0xffffu); o[3 * (size_t)S] = (bf16_t)(w.y >> 16);
                        o[4 * (size_t)S] = (bf16_t)(w.z & 0xffffu); o[5 * (size_t)S] = (bf16_t)(w.z >> 16); o[6 * (size_t)S] = (bf16_t)(w.w & 0xffffu); o[7 * (size_t)S] = (bf16_t)(w.w >> 16);
                    }
                }
        } else {
            bf16_t* O; int ld; float sc = 1.f; bool sg = false;
            if (t < 15) { O = SBb + (t - 12) * BM; ld = CW; }
            else if (t < 21) { O = Q + (t - 15) * BM; ld = AW; sc = QSCALE; }
            else if (t == 21) { O = Kb; ld = KVW; }
            else { O = SG + (t - 23) * BM; ld = NG; sg = true; }
            O += cw;
            LOAD_BV();
#pragma unroll
            for (int ai = 0; ai < 2; ++ai)
#pragma unroll
                for (int m = 0; m < 4; ++m) {
                    const int row = row0 + ai * HALF + m * 16;
#pragma unroll
                    for (int bj = 0; bj < 2; ++bj) {
                        f32x4 v0 = acc[ai][bj][m][0] + bv[bj][0], v1 = acc[ai][bj][m][1] + bv[bj][1];
                        if (sg) { v0 = sig4(clamp4(v0, -60.f, 60.f)); v1 = sig4(clamp4(v1, -60.f, 60.f)); } else { v0 = v0 * sc; v1 = v1 * sc; }
                        *(u32x4*)(O + (size_t)row * ld + bj * HALF) = pack8(v0, v1);
                    }
                }
        }
    }
};

struct EpiGates {
    const float* bias; bf16_t* SG;
    __device__ __forceinline__ void operator()(const f32x4 (&acc)[2][2][4][2], const Unit& u, int wr, int wc, int fr, int fq) const {
        const int row0 = u.pm * BM + wr * 64 + fr, col0 = u.pn * BM + wc * 32 + 8 * fq;
        f32x4 bv[2][2];
#pragma unroll
        for (int bj = 0; bj < 2; ++bj)
#pragma unroll
            for (int n = 0; n < 2; ++n) bv[bj][n] = *(const f32x4*)(bias + col0 + bj * HALF + 4 * n);
#pragma unroll
        for (int ai = 0; ai < 2; ++ai)
#pragma unroll
            for (int m = 0; m < 4; ++m)
#pragma unroll
                for (int bj = 0; bj < 2; ++bj) {
                    const f32x4 v0 = sig4(clamp4(acc[ai][bj][m][0] * GQ_DESCALE + bv[bj][0], -60.f, 60.f)), v1 = sig4(clamp4(acc[ai][bj][m][1] * GQ_DESCALE + bv[bj][1], -60.f, 60.f));
                    *(u32x4*)(SG + (size_t)(row0 + ai * HALF + m * 16) * NG + col0 + bj * HALF) = pack8(v0, v1);
                }
    }
};

__device__ __forceinline__ f32x4 up_lo(u32x2 p) { return (f32x4){bf_lo(p.x), bf_hi(p.x), bf_lo(p.y), bf_hi(p.y)}; }
__device__ __forceinline__ f32x4 rcp4(f32x4 v) { f32x4 r; for (int i = 0; i < 4; ++i) r[i] = __builtin_amdgcn_rcpf(v[i]); return r; }

struct EpiMerge {
    static constexpr int MID1 = CW / BK, MID2 = 2 * CW / BK;
    const bf16_t* SG; bf16_t* MG;
    __device__ __forceinline__ void mid(f32x4 (&acc)[2][2][4][2], const Unit& u, int which, int wr, int wc, int fr, int fq) const {
        const unsigned loff = (unsigned)(fr * NG + 8 * fq) * 2u;
        const char* nb = (const char*)SG + ((size_t)(u.pm * BM + wr * 64) * NG + (size_t)which * D + u.pn * BM + wc * 32) * 2;
#pragma unroll
        for (int ai = 0; ai < 2; ++ai)
#pragma unroll
            for (int bj = 0; bj < 2; ++bj) {
                u32x4 nv[4], dv[4];
#pragma unroll
                for (int m = 0; m < 4; ++m) { const char* p = nb + ((size_t)(ai * HALF + m * 16) * NG + bj * HALF) * 2; nv[m] = *(const u32x4*)(p + loff); dv[m] = *(const u32x4*)(p + (size_t)D * 2 + loff); }
#pragma unroll
                for (int m = 0; m < 4; ++m) {
                    const f32x4 r0 = up_lo((u32x2){nv[m].x, nv[m].y}) * rcp4(up_lo((u32x2){dv[m].x, dv[m].y}));
                    const f32x4 r1 = up_lo((u32x2){nv[m].z, nv[m].w}) * rcp4(up_lo((u32x2){dv[m].z, dv[m].w}));
                    acc[ai][bj][m][0] = acc[ai][bj][m][0] * r0; acc[ai][bj][m][1] = acc[ai][bj][m][1] * r1;
                }
                __builtin_amdgcn_sched_barrier(0);
            }
    }
    __device__ __forceinline__ void operator()(const f32x4 (&acc)[2][2][4][2], const Unit& u, int wr, int wc, int fr, int fq) const {
        const unsigned loff = (unsigned)(fr * NG + 8 * fq) * 2u, loffo = (unsigned)(fr * D + 8 * fq) * 2u;
        const char* gb = (const char*)SG + ((size_t)(u.pm * BM + wr * 64) * NG + (size_t)2 * D + u.pn * BM + wc * 32) * 2;
        char* ob = (char*)MG + ((size_t)(u.pm * BM + wr * 64) * D + u.pn * BM + wc * 32) * 2;
#pragma unroll
        for (int ai = 0; ai < 2; ++ai)
#pragma unroll
            for (int bj = 0; bj < 2; ++bj) {
                u32x4 gv[4];
#pragma unroll
                for (int m = 0; m < 4; ++m) gv[m] = *(const u32x4*)(gb + ((size_t)(ai * HALF + m * 16) * NG + bj * HALF) * 2 + loff);
#pragma unroll
                for (int m = 0; m < 4; ++m) {
                    const f32x4 v0 = acc[ai][bj][m][0] * up_lo((u32x2){gv[m].x, gv[m].y}), v1 = acc[ai][bj][m][1] * up_lo((u32x2){gv[m].z, gv[m].w});
                    *(u32x4*)(ob + ((size_t)(ai * HALF + m * 16) * D + bj * HALF) * 2 + loffo) = pack8(v0, v1);
                }
                __builtin_amdgcn_sched_barrier(0);
            }
    }
};

struct EpiResid {
    const float* R; const float* bias; float* O;
    __device__ __forceinline__ void operator()(const f32x4 (&acc)[2][2][4][2], const Unit& u, int wr, int wc, int fr, int fq) const {
        const int row0 = u.pm * BM + wr * 64 + fr, col0 = u.pn * BM + wc * 32 + 8 * fq;
        f32x4 bv[2][2];
#pragma unroll
        for (int bj = 0; bj < 2; ++bj)
#pragma unroll
            for (int n = 0; n < 2; ++n) bv[bj][n] = *(const f32x4*)(bias + col0 + bj * HALF + 4 * n);
#pragma unroll
        for (int ai = 0; ai < 2; ++ai) {
            f32x4 rv[4][2][2];
#pragma unroll
            for (int m = 0; m < 4; ++m)
#pragma unroll
                for (int bj = 0; bj < 2; ++bj)
#pragma unroll
                    for (int n = 0; n < 2; ++n) rv[m][bj][n] = *(const f32x4*)(R + (size_t)(row0 + ai * HALF + m * 16) * D + col0 + bj * HALF + 4 * n);
#pragma unroll
            for (int m = 0; m < 4; ++m)
#pragma unroll
                for (int bj = 0; bj < 2; ++bj)
#pragma unroll
                    for (int n = 0; n < 2; ++n) *(f32x4*)(O + (size_t)(row0 + ai * HALF + m * 16) * D + col0 + bj * HALF + 4 * n) = rv[m][bj][n] * ALPHA + acc[ai][bj][m][n] + bv[bj][n];
            __builtin_amdgcn_sched_barrier(0);
        }
    }
};

struct EpiRelu2 {
    const float* bias; bf16_t* O;
    __device__ __forceinline__ void operator()(const f32x4 (&acc)[2][2][4][2], const Unit& u, int wr, int wc, int fr, int fq) const {
        const int row0 = u.pm * BM + wr * 64 + fr, col0 = u.pn * BM + wc * 32 + 8 * fq;
        f32x4 bv[2][2];
#pragma unroll
        for (int bj = 0; bj < 2; ++bj)
#pragma unroll
            for (int n = 0; n < 2; ++n) bv[bj][n] = *(const f32x4*)(bias + col0 + bj * HALF + 4 * n);
#pragma unroll
        for (int ai = 0; ai < 2; ++ai)
#pragma unroll
            for (int m = 0; m < 4; ++m)
#pragma unroll
                for (int bj = 0; bj < 2; ++bj) {
                    f32x4 v0 = acc[ai][bj][m][0] + bv[bj][0], v1 = acc[ai][bj][m][1] + bv[bj][1];
#pragma unroll
                    for (int i = 0; i < 4; ++i) { v0[i] = fmaxf(v0[i], 0.f); v0[i] *= v0[i]; v1[i] = fmaxf(v1[i], 0.f); v1[i] *= v1[i]; }
                    *(u32x4*)(O + (size_t)(row0 + ai * HALF + m * 16) * FF + col0 + bj * HALF) = pack8(v0, v1);
                }
    }
};
}

__host__ __device__ __forceinline__ int inproj_dst_row(int o) {
    if (o < 768) return 256 * (o / 128) + (o % 128);
    if (o < 1536) { const int c = o - 768; return 256 * (c / 128) + 128 + (c % 128); }
    if (o < 2304) return 12 * 256 + (o - 1536);
    if (o < 3072) { const int c = o - 2304; return 256 * (6 + c / 128) + (c % 128); }
    if (o < 3840) { const int c = o - 3072; return 256 * (6 + c / 128) + 128 + (c % 128); }
    return o;
}

__device__ __forceinline__ void transpose_item(const float* __restrict__ W, int N, bf16_t* WT, int K, int k0, int n0, int dst_row, LAS float* scr, int lane) {
    const int kr = lane >> 3, nc = lane & 7;
    f32x4 v[8];
#pragma unroll
    for (int i = 0; i < 8; ++i) v[i] = *(const f32x4*)(W + (size_t)(k0 + 8 * i + kr) * N + n0 + 4 * nc);
#pragma unroll
    for (int i = 0; i < 8; ++i) { LAS float* s = scr + (8 * i + kr) * 33 + 4 * nc; s[0] = v[i][0]; s[1] = v[i][1]; s[2] = v[i][2]; s[3] = v[i][3]; }
    LDS_WAIT();
    const int c = lane & 7;
#pragma unroll
    for (int j = 0; j < 4; ++j) { const int n = (lane >> 3) + 8 * j; const LAS float* s = scr + (8 * c) * 33 + n;
        u32x4 o; o.x = cvt_pk_bf16(s[0 * 33], s[1 * 33]); o.y = cvt_pk_bf16(s[2 * 33], s[3 * 33]); o.z = cvt_pk_bf16(s[4 * 33], s[5 * 33]); o.w = cvt_pk_bf16(s[6 * 33], s[7 * 33]);
        *(u32x4*)(WT + (size_t)(dst_row + n) * K + k0 + 8 * c) = o; }
    LDS_WAIT();
}

__device__ __forceinline__ unsigned pk4_fp8(float a, float b, float c, float d) { unsigned w = 0u; w = __builtin_amdgcn_cvt_pk_fp8_f32(a, b, w, false); w = __builtin_amdgcn_cvt_pk_fp8_f32(c, d, w, true); return w; }
__device__ __forceinline__ void transpose_item_fp8(const float* __restrict__ W, int N, unsigned char* WT8, int K, int k0, int n0, int dst_row, LAS float* scr, int lane) {
    const int kr = lane >> 3, nc = lane & 7;
    f32x4 v[8];
#pragma unroll
    for (int i = 0; i < 8; ++i) v[i] = *(const f32x4*)(W + (size_t)(k0 + 8 * i + kr) * N + n0 + 4 * nc);
#pragma unroll
    for (int i = 0; i < 8; ++i) { LAS float* s = scr + (8 * i + kr) * 33 + 4 * nc; s[0] = v[i][0] * WQ_SCALE; s[1] = v[i][1] * WQ_SCALE; s[2] = v[i][2] * WQ_SCALE; s[3] = v[i][3] * WQ_SCALE; }
    LDS_WAIT();
    const int c = lane & 3;
#pragma unroll
    for (int j = 0; j < 2; ++j) { const int n = (lane >> 2) + 16 * j; const LAS float* s = scr + (16 * c) * 33 + n;
        u32x4 o; o.x = pk4_fp8(s[0 * 33], s[1 * 33], s[2 * 33], s[3 * 33]); o.y = pk4_fp8(s[4 * 33], s[5 * 33], s[6 * 33], s[7 * 33]);
        o.z = pk4_fp8(s[8 * 33], s[9 * 33], s[10 * 33], s[11 * 33]); o.w = pk4_fp8(s[12 * 33], s[13 * 33], s[14 * 33], s[15 * 33]);
        *(u32x4*)(WT8 + (size_t)(dst_row + n) * K + k0 + 16 * c) = o; }
    LDS_WAIT();
}

struct LayerW { bf16_t *WinT, *WbT, *WoT, *W1T, *W2T; unsigned char* WgQ; };
__device__ __forceinline__ LayerW layer_w(unsigned char* ws, int l) {
    unsigned char* b = ws + WS_W + (size_t)l * W_LAYER_B; LayerW w;
    w.WgQ = ws + WS_WG + (size_t)l * W_G_B;
    w.WinT = (bf16_t*)b; w.WbT = (bf16_t*)(b + W_IN_B); w.WoT = (bf16_t*)(b + W_IN_B + W_B_B); w.W1T = (bf16_t*)(b + W_IN_B + W_B_B + W_O_B); w.W2T = (bf16_t*)(b + W_IN_B + W_B_B + W_O_B + W_1_B);
    return w;
}

__device__ __forceinline__ void convert_phase(const float* w_in, const float* w_br, const float* w_out, const float* w_1, const float* w_2, const float* b_in, const LayerW& W, float* biasP,
                                              LAS unsigned char* lds, int gw, int NGW, int wave, int lane, int gtid, int NGT) {
    LAS float* scr = (LAS float*)(lds + wave * 16384);
    constexpr int I_IN = (D / 64) * (NIN / 32), I_B = (MIXW / 64) * (D / 32), I_O = (D / 64) * (D / 32), I_1 = (D / 64) * (FF / 32), I_2 = (FF / 64) * (D / 32);
    constexpr int NITEMS = I_IN + I_B + I_O + I_1 + I_2;
    for (int it = gw; it < NITEMS; it += NGW) {
        int r = it;
        if (r < I_IN) { const int nb = r % (NIN / 32), kb = r / (NIN / 32);
            if (32 * nb < NBF) transpose_item(w_in, NIN, W.WinT, D, 64 * kb, 32 * nb, inproj_dst_row(32 * nb), scr, lane);
            else transpose_item_fp8(w_in, NIN, W.WgQ, D, 64 * kb, 32 * nb, 32 * nb - NBF, scr, lane);
            continue; } r -= I_IN;
        if (r < I_B) { const int nb = r % (D / 32), kb = r / (D / 32); transpose_item(w_br, D, W.WbT, MIXW, 64 * kb, 32 * nb, 32 * nb, scr, lane); continue; } r -= I_B;
        if (r < I_O) { const int nb = r % (D / 32), kb = r / (D / 32); transpose_item(w_out, D, W.WoT, D, 64 * kb, 32 * nb, 32 * nb, scr, lane); continue; } r -= I_O;
        if (r < I_1) { const int nb = r % (FF / 32), kb = r / (FF / 32); transpose_item(w_1, FF, W.W1T, D, 64 * kb, 32 * nb, 32 * nb, scr, lane); continue; } r -= I_1;
        { const int nb = r % (D / 32), kb = r / (D / 32); transpose_item(w_2, D, W.W2T, FF, 64 * kb, 32 * nb, 32 * nb, scr, lane); }
    }
    for (int o = gtid; o < NIN; o += NGT) biasP[inproj_dst_row(o)] = b_in[o];
}

__device__ __forceinline__ void cvt_rows_phase(const float* X, bf16_t* XB, unsigned char* XQ, int gtid, int NGT) {
    for (size_t i = (size_t)gtid; i < (size_t)S * D / 8; i += (size_t)NGT) {
        const f32x4 a = *(const f32x4*)(X + i * 8), b = *(const f32x4*)(X + i * 8 + 4);
        *(u32x4*)(XB + i * 8) = pg8::pack8(a, b);
        *(u32x2*)(XQ + i * 8) = (u32x2){pk4_fp8(a[0] * XQ_SCALE, a[1] * XQ_SCALE, a[2] * XQ_SCALE, a[3] * XQ_SCALE), pk4_fp8(b[0] * XQ_SCALE, b[1] * XQ_SCALE, b[2] * XQ_SCALE, b[3] * XQ_SCALE)};
    }
}

__device__ __forceinline__ void ln_phase(const float* V, const float* g, const float* b, float* OF, bf16_t* OB, unsigned char* OQ, int gw, int NGW, int lane) {
    for (int row = gw; row < S; row += NGW) {
        const f32x4* vr = (const f32x4*)(V + (size_t)row * D) + lane;
        f32x4 v[16]; float s = 0.f;
#pragma unroll
        for (int j = 0; j < 16; ++j) { v[j] = vr[64 * j]; s += (v[j][0] + v[j][1]) + (v[j][2] + v[j][3]); }
        const float mean = wave_sum(s) * (1.f / D); float s2 = 0.f;
#pragma unroll
        for (int j = 0; j < 16; ++j) { v[j] = v[j] - mean; s2 += (v[j][0] * v[j][0] + v[j][1] * v[j][1]) + (v[j][2] * v[j][2] + v[j][3] * v[j][3]); }
        const float rstd = 1.f / sqrtf(wave_sum(s2) * (1.f / D) + LN_EPS);
        f32x4* of = (f32x4*)(OF + (size_t)row * D) + lane; u32x2* ob = (u32x2*)(OB + (size_t)row * D) + lane;
#pragma unroll
        for (int j = 0; j < 16; ++j) {
            const f32x4 gg = ((const f32x4*)g)[64 * j + lane], bb = ((const f32x4*)b)[64 * j + lane];
            const f32x4 y = v[j] * rstd * gg + bb;
            of[64 * j] = y; ob[64 * j] = (u32x2){cvt_pk_bf16(y[0], y[1]), cvt_pk_bf16(y[2], y[3])};
            if (OQ) ((unsigned*)(OQ + (size_t)row * D))[64 * j + lane] = pk4_fp8(y[0] * XQ_SCALE, y[1] * XQ_SCALE, y[2] * XQ_SCALE, y[3] * XQ_SCALE);
        }
    }
}

__device__ __forceinline__ void convB_phase(const bf16_t* CX, const bf16_t* SBb, const float* w3, bf16_t* Y, int gtid, int NGT) {
    for (int idx = gtid; idx < S * (CW / 8); idx += NGT) {
        const int t = idx / (CW / 8), c = (idx % (CW / 8)) * 8;
        const u32x4 z = (u32x4){0u, 0u, 0u, 0u};
        const u32x4 x2 = *(const u32x4*)(CX + (size_t)t * CW + c);
        const u32x4 x1 = t >= 1 ? *(const u32x4*)(CX + (size_t)(t - 1) * CW + c) : z;
        const u32x4 x0 = t >= 2 ? *(const u32x4*)(CX + (size_t)(t - 2) * CW + c) : z;
        const u32x4 sb = *(const u32x4*)(SBb + (size_t)t * CW + c);
        float o[8];
#pragma unroll
        for (int e = 0; e < 4; ++e) {
            const f32x2 w0 = *(const f32x2*)(w3 + 0 * CW + c + 2 * e), w1 = *(const f32x2*)(w3 + 1 * CW + c + 2 * e), w2 = *(const f32x2*)(w3 + 2 * CW + c + 2 * e);
            o[2 * e] = bf_lo(sb[e]) * (w0[0] * bf_lo(x0[e]) + w1[0] * bf_lo(x1[e]) + w2[0] * bf_lo(x2[e]));
            o[2 * e + 1] = bf_hi(sb[e]) * (w0[1] * bf_hi(x0[e]) + w1[1] * bf_hi(x1[e]) + w2[1] * bf_hi(x2[e]));
        }
        u32x4 w; w.x = cvt_pk_bf16(o[0], o[1]); w.y = cvt_pk_bf16(o[2], o[3]); w.z = cvt_pk_bf16(o[4], o[5]); w.w = cvt_pk_bf16(o[6], o[7]);
        *(u32x4*)(Y + (size_t)t * MIXW + CW + c) = w;
    }
}

__device__ __forceinline__ void convA_unit(const bf16_t* U, const float* w, const float* cb, const float* g, const float* b, bf16_t* Y, int r0, LAS unsigned char* lds, int tid, int wave, int lane) {
    for (int c = tid; c < 62 * 96; c += 512) { const int rr = c / 96, cc = c % 96, gr = r0 - 30 + rr;
        const u32x4 v = gr >= 0 ? *(const u32x4*)(U + (size_t)gr * CW + cc * 8) : (u32x4){0u, 0u, 0u, 0u};
        *(LAS u32x4*)(lds + rr * 1536 + cc * 16) = v; }
    __syncthreads();
    f32x2 acc[4][6], w0[6], w1[6], w2[6], w3[6];
#pragma unroll
    for (int j = 0; j < 6; ++j) { w1[j] = (f32x2){0.f, 0.f}; w2[j] = w1[j]; w3[j] = w1[j]; w0[j] = w1[j];
#pragma unroll
        for (int r = 0; r < 4; ++r) acc[r][j] = (f32x2){0.f, 0.f}; }
    const LAS unsigned char* lrow = lds + (4 * wave) * 1536 + lane * 4;
#pragma unroll 2
    for (int i = 0; i < 34; ++i) {
#pragma unroll
        for (int j = 0; j < 6; ++j) { w3[j] = w2[j]; w2[j] = w1[j]; w1[j] = w0[j]; w0[j] = (i <= 30) ? *(const f32x2*)(w + (size_t)(i <= 30 ? i : 30) * CW + 2 * lane + 128 * j) : (f32x2){0.f, 0.f}; }
#pragma unroll
        for (int j = 0; j < 6; ++j) {
            const unsigned p = *(const LAS unsigned*)(lrow + i * 1536 + j * 256);
            const f32x2 uu = (f32x2){bf_lo(p), bf_hi(p)};
            acc[0][j] += w0[j] * uu; acc[1][j] += w1[j] * uu; acc[2][j] += w2[j] * uu; acc[3][j] += w3[j] * uu;
        }
    }
#pragma unroll
    for (int r = 0; r < 4; ++r) {
        const int row = r0 + 4 * wave + r; float s = 0.f;
#pragma unroll
        for (int j = 0; j < 6; ++j) { acc[r][j] += *(const f32x2*)(cb + 2 * lane + 128 * j); s += acc[r][j][0] + acc[r][j][1]; }
        const float mean = wave_sum(s) * (1.f / CW); float s2 = 0.f;
#pragma unroll
        for (int j = 0; j < 6; ++j) { acc[r][j] = acc[r][j] - mean; s2 += acc[r][j][0] * acc[r][j][0] + acc[r][j][1] * acc[r][j][1]; }
        const float rstd = 1.f / sqrtf(wave_sum(s2) * (1.f / CW) + LN_EPS);
#pragma unroll
        for (int j = 0; j < 6; ++j) {
            const f32x2 gg = *(const f32x2*)(g + 2 * lane + 128 * j), bb = *(const f32x2*)(b + 2 * lane + 128 * j);
            f32x2 y = acc[r][j] * rstd * gg + bb; y[0] = y[0] * sigmoidf_fast(y[0]); y[1] = y[1] * sigmoidf_fast(y[1]);
            *(unsigned*)(Y + (size_t)row * MIXW + 2 * lane + 128 * j) = cvt_pk_bf16(y[0], y[1]);
        }
    }
    __syncthreads();
}

__device__ __forceinline__ void attn_item(const bf16_t* Q, const bf16_t* Kb, const bf16_t* VT, bf16_t* Y, const float* sinks, int qb, int h, int lane) {
    const int fr = lane & 15, fq = lane >> 4, kvh = h / 6, q0 = qb * 16, kstart = q0 - 144;
    const float slope = (h < 16) ? __builtin_amdgcn_exp2f(-0.5f * (float)(h + 1)) : __builtin_amdgcn_exp2f(-0.25f * (float)(2 * (h - 16) + 1));
    const float slope2 = slope * L2E, sink2 = sinks[h] * L2E;
    const bf16_t* qp = Q + (size_t)(q0 + fr) * AW + h * HD + fq * 8;
    const bf16x8 qf0 = *(const bf16x8*)qp, qf1 = *(const bf16x8*)(qp + 32);
    f32x4 s[10];
#pragma unroll
    for (int kt = 1; kt < 10; ++kt) {
        int key = kstart + kt * 16 + fr; key = key < 0 ? 0 : key;
        const bf16_t* kp = Kb + (size_t)key * KVW + kvh * HD + fq * 8;
        const bf16x8 k0 = *(const bf16x8*)kp, k1 = *(const bf16x8*)(kp + 32);
        f32x4 z = (f32x4){0.f, 0.f, 0.f, 0.f};
        z = __builtin_amdgcn_mfma_f32_16x16x32_bf16(k0, qf0, z, 0, 0, 0);
        z = __builtin_amdgcn_mfma_f32_16x16x32_bf16(k1, qf1, z, 0, 0, 0);
        s[kt] = z;
    }
    const int qpos = q0 + fr; float mx = sink2;
#pragma unroll
    for (int kt = 1; kt < 10; ++kt)
#pragma unroll
        for (int i = 0; i < 4; ++i) {
            const int key = kstart + kt * 16 + fq * 4 + i, dist = qpos - key;
            const bool valid = (dist >= 0) && (dist < 128) && (key >= 0);
            const float v = valid ? (s[kt][i] - slope2 * (float)dist) : -__builtin_inff();
            s[kt][i] = v; mx = fmaxf(mx, v);
        }
    mx = fmaxf(mx, __shfl_xor(mx, 16)); mx = fmaxf(mx, __shfl_xor(mx, 32));
    float sum = 0.f;
#pragma unroll
    for (int kt = 1; kt < 10; ++kt)
#pragma unroll
        for (int i = 0; i < 4; ++i) { const float p = __builtin_amdgcn_exp2f(s[kt][i] - mx); s[kt][i] = p; sum += p; }
    sum += __shfl_xor(sum, 16); sum += __shfl_xor(sum, 32);
    sum += __builtin_amdgcn_exp2f(sink2 - mx);
    const float inv = 1.f / sum;
    s[0] = (f32x4){0.f, 0.f, 0.f, 0.f};
    f32x4 o[4];
#pragma unroll
    for (int dt = 0; dt < 4; ++dt) o[dt] = (f32x4){0.f, 0.f, 0.f, 0.f};
#pragma unroll
    for (int c = 0; c < 5; ++c) {
        const u32x4 pw = pg8::pack8(s[2 * c], s[2 * c + 1]);
        const bf16x8 pf = __builtin_bit_cast(bf16x8, pw);
        int kg0 = kstart + 32 * c + fq * 4, kg1 = kg0 + 16; kg0 = kg0 < 0 ? 0 : kg0; kg1 = kg1 < 0 ? 0 : kg1;
#pragma unroll
        for (int dt = 0; dt < 4; ++dt) {
            const bf16_t* vp = VT + (size_t)(kvh * HD + dt * 16 + fr) * S;
            const u32x2 lo = *(const u32x2*)(vp + kg0), hi = *(const u32x2*)(vp + kg1);
            const bf16x8 vf = __builtin_bit_cast(bf16x8, (u32x4){lo.x, lo.y, hi.x, hi.y});
            o[dt] = __builtin_amdgcn_mfma_f32_16x16x32_bf16(vf, pf, o[dt], 0, 0, 0);
        }
    }
    bf16_t* yp = Y + (size_t)(q0 + fr) * MIXW + 2 * CW + h * HD + fq * 4;
#pragma unroll
    for (int dt = 0; dt < 4; ++dt) { const f32x4 v = o[dt] * inv; *(u32x2*)(yp + dt * 16) = (u32x2){cvt_pk_bf16(v[0], v[1]), cvt_pk_bf16(v[2], v[3])}; }
}

constexpr int NPH = 10, NPHASES = DEPTH * NPH;
struct Args { const float* in[20]; float* out; unsigned char* ws; int ph_lo, ph_hi, one, pad; };
typedef const __attribute__((address_space(4))) Args* CArgsP;
#ifndef PH_MASK
#define PH_MASK 0x3ff
#endif
#ifndef PROBE_DUP
#define PROBE_DUP 0
#endif
#define DUPN(k) (1 + ((PROBE_DUP >> (k)) & 1))

#define PHASE_BEGIN() CArgsP p = ap; asm volatile("" : "+s"(p)); int tz = threadIdx.x; asm volatile("" : "+v"(tz)); \
    const int lane = tz & 63, wave = __builtin_amdgcn_readfirstlane(tz >> 6); unsigned char* ws = p->ws; (void)lane; (void)wave; (void)ws; \
    const int G = gridDim.x, bx = blockIdx.x, vcu = (G % 8 == 0) ? (bx % 8) * (G / 8) + bx / 8 : bx, NGW = G * 8, NGT = G * 512; (void)NGW; (void)NGT; (void)vcu
#define GW() (vcu * 8 + wave)
#define GTID() (vcu * 512 + tz)

__global__ void __launch_bounds__(512, 2) fwd(Args a_unused) {
    extern __shared__ __attribute__((aligned(16))) unsigned char lds_raw[];
    LAS unsigned char* lds = (LAS unsigned char*)lds_raw;
    const CArgsP ap = (CArgsP)__builtin_amdgcn_kernarg_segment_ptr();
    for (int u = threadIdx.x; u < (LDS_BYTES - RING_BYTES) / 4; u += 512) ((LAS unsigned*)(lds + RING_BYTES))[u] = 0u;
    __syncthreads();
    if (ap->one) (void)xcd_barrier_post((unsigned*)(ap->ws + WS_CTL) + CW_BAR, (volatile LAS unsigned*)(lds + MISC_OFF) + 8);
#define IN(k) (((PH_MASK >> ((k) % NPH)) & 1) && ap->ph_lo <= (k) && (k) < ap->ph_hi)
#define GRID_BAR(k) do { if (IN(k) && IN((k) + 1)) { XcdBarrier xb_; xb_.bar = (unsigned*)(ws + WS_CTL) + CW_BAR; xb_.x = xb_xcc_id(); xb_.st = (volatile LAS unsigned*)(lds + MISC_OFF) + 8; xcd_barrier(xb_); } } while (0)

    for (int l = 0; l < DEPTH; ++l) {
        const int pb = l * NPH;
        if (IN(pb + 0)) for (int dup_ = 0; dup_ < DUPN(0); ++dup_) {
            PHASE_BEGIN();
            const LayerW W = layer_w(ws, l);
            convert_phase(p->in[1] + (size_t)l * D * NIN, p->in[9] + (size_t)l * MIXW * D, p->in[10] + (size_t)l * D * D, p->in[14] + (size_t)l * D * FF, p->in[16] + (size_t)l * FF * D,
                          p->in[2] + (size_t)l * NIN, W, (float*)(ws + WS_BIASP + (size_t)l * 131072), lds, GW(), NGW, wave, lane, GTID(), NGT);
            if (l == 0) cvt_rows_phase(p->in[0], (bf16_t*)(ws + WS_XB), ws + WS_XQ, GTID(), NGT);
            GRID_BAR(pb + 0);
        }
        if (IN(pb + 1)) for (int dup_ = 0; dup_ < DUPN(1); ++dup_) {
            PHASE_BEGIN();
            const LayerW W = layer_w(ws, l);
            { pg8::Gemm g{ws + WS_XB, W.WinT, D * 2, D * 2, D / 64}; pg8::StaticOrder So; So.init(S, NBF, G, bx);
              pg8::EpiInProj E{(const float*)(ws + WS_BIASP + (size_t)l * 131072), (bf16_t*)(ws + WS_U), (bf16_t*)(ws + WS_CX), (bf16_t*)(ws + WS_SB), (bf16_t*)(ws + WS_Q), (bf16_t*)(ws + WS_K), (bf16_t*)(ws + WS_VT), (bf16_t*)(ws + WS_SG)};
              pg8::gemm_phase<pg8::EpiInProj, false>(lds, g, So, E, tz); }
            GRID_BAR(pb + 1);
        }
        if (IN(pb + 2)) for (int dup_ = 0; dup_ < DUPN(2); ++dup_) {
            PHASE_BEGIN();
            const LayerW W = layer_w(ws, l);
            { pg8::Gemm g{ws + WS_XQ, W.WgQ, D, D, D / 128}; pg8::StaticOrder So; So.init(S, NG, G, bx);
              pg8::EpiGates E{(const float*)(ws + WS_BIASP + (size_t)l * 131072) + NBF, (bf16_t*)(ws + WS_SG)};
              pg8::gemm_phase<pg8::EpiGates, false, true>(lds, g, So, E, tz); }
            GRID_BAR(pb + 2);
        }
        if (IN(pb + 3)) for (int dup_ = 0; dup_ < DUPN(3); ++dup_) {
            PHASE_BEGIN();
            bf16_t* Yb = (bf16_t*)(ws + WS_Y);
            for (int un = vcu; un < S / 32; un += G)
                convA_unit((const bf16_t*)(ws + WS_U), p->in[3] + (size_t)l * 31 * CW, p->in[4] + (size_t)l * CW, p->in[5] + (size_t)l * CW, p->in[6] + (size_t)l * CW, Yb, un * 32, lds, tz, wave, lane);
            convB_phase((const bf16_t*)(ws + WS_CX), (const bf16_t*)(ws + WS_SB), p->in[7] + (size_t)l * 3 * CW, Yb, GTID(), NGT);
            for (int it = GW(); it < (S / 16) * NQH; it += NGW)
                attn_item((const bf16_t*)(ws + WS_Q), (const bf16_t*)(ws + WS_K), (const bf16_t*)(ws + WS_VT), Yb, p->in[8] + (size_t)l * NQH, it % (S / 16), it / (S / 16), lane);
            GRID_BAR(pb + 3);
        }
        if (IN(pb + 4)) for (int dup_ = 0; dup_ < DUPN(4); ++dup_) {
            PHASE_BEGIN();
            const LayerW W = layer_w(ws, l);
            pg8::Gemm g{ws + WS_Y, W.WbT, MIXW * 2, MIXW * 2, MIXW / 64}; pg8::StaticOrder So; So.init(S, D, G, bx);
            pg8::EpiMerge E{(const bf16_t*)(ws + WS_SG), (bf16_t*)(ws + WS_MG)};
            pg8::gemm_phase<pg8::EpiMerge, true>(lds, g, So, E, tz);
            GRID_BAR(pb + 4);
        }
        if (IN(pb + 5)) for (int dup_ = 0; dup_ < DUPN(5); ++dup_) {
            PHASE_BEGIN();
            const LayerW W = layer_w(ws, l);
            pg8::Gemm g{ws + WS_MG, W.WoT, D * 2, D * 2, D / 64}; pg8::StaticOrder So; So.init(S, D, G, bx);
            pg8::EpiResid E{l == 0 ? p->in[0] : (const float*)(ws + WS_XF), p->in[11] + (size_t)l * D, (float*)(ws + WS_V)};
            pg8::gemm_phase<pg8::EpiResid, false>(lds, g, So, E, tz);
            GRID_BAR(pb + 5);
        }
        if (IN(pb + 6)) for (int dup_ = 0; dup_ < DUPN(6); ++dup_) {
            PHASE_BEGIN();
            ln_phase((const float*)(ws + WS_V), p->in[12] + (size_t)l * D, p->in[13] + (size_t)l * D, (float*)(ws + WS_X1F), (bf16_t*)(ws + WS_X1B), nullptr, GW(), NGW, lane);
            GRID_BAR(pb + 6);
        }
        if (IN(pb + 7)) for (int dup_ = 0; dup_ < DUPN(7); ++dup_) {
            PHASE_BEGIN();
            const LayerW W = layer_w(ws, l);
            pg8::Gemm g{ws + WS_X1B, W.W1T, D * 2, D * 2, D / 64}; pg8::StaticOrder So; So.init(S, FF, G, bx);
            pg8::EpiRelu2 E{p->in[15] + (size_t)l * FF, (bf16_t*)(ws + WS_HID)};
            pg8::gemm_phase<pg8::EpiRelu2, false>(lds, g, So, E, tz);
            GRID_BAR(pb + 7);
        }
        if (IN(pb + 8)) for (int dup_ = 0; dup_ < DUPN(8); ++dup_) {
            PHASE_BEGIN();
            const LayerW W = layer_w(ws, l);
            pg8::Gemm g{ws + WS_HID, W.W2T, FF * 2, FF * 2, FF / 64}; pg8::StaticOrder So; So.init(S, D, G, bx);
            pg8::EpiResid E{(const float*)(ws + WS_X1F), p->in[17] + (size_t)l * D, (float*)(ws + WS_V)};
            pg8::gemm_phase<pg8::EpiResid, false>(lds, g, So, E, tz);
            GRID_BAR(pb + 8);
        }
        if (IN(pb + 9)) for (int dup_ = 0; dup_ < DUPN(9); ++dup_) {
            PHASE_BEGIN();
            ln_phase((const float*)(ws + WS_V), p->in[18] + (size_t)l * D, p->in[19] + (size_t)l * D, l == DEPTH - 1 ? p->out : (float*)(ws + WS_XF), (bf16_t*)(ws + WS_XB), ws + WS_XQ, GW(), NGW, lane);
            GRID_BAR(pb + 9);
        }
    }
#undef IN
#undef GRID_BAR
}

extern "C" void kernel_launch(void* const* d_in, const int* in_sizes, int n_in, void* d_out, int out_size, void* d_ws, size_t ws_size, hipStream_t stream) {
    static int grid = 0;
    if (grid == 0) {
        if (n_in != 20 || in_sizes[0] != S * D || out_size != S * D || ws_size < WS_END) {
            fprintf(stderr, "kernel_launch: unexpected shapes (n_in %d, in0 %d, out %d, ws %zu, need %zu); nothing launched\n", n_in, n_in > 0 ? in_sizes[0] : -1, out_size, ws_size, (size_t)WS_END); grid = -1; return; }
        int dev = 0, cus = 0, per_cu = 0;
        if (hipGetDevice(&dev) != hipSuccess || hipDeviceGetAttribute(&cus, hipDeviceAttributeMultiprocessorCount, dev) != hipSuccess) { grid = -1; return; }
        if (hipFuncSetAttribute((const void*)fwd, hipFuncAttributeMaxDynamicSharedMemorySize, LDS_BYTES) != hipSuccess) { fprintf(stderr, "kernel_launch: hipFuncSetAttribute failed\n"); grid = -1; return; }
        if (hipOccupancyMaxActiveBlocksPerMultiprocessor(&per_cu, (const void*)fwd, 512, LDS_BYTES) != hipSuccess || per_cu < 1) fprintf(stderr, "kernel_launch: occupancy query reports %d\n", per_cu);
        (void)hipGetLastError();
        grid = cus;
    }
    if (grid < 0) return;
    (void)hipMemsetAsync((char*)d_ws + WS_CTL, 0, CTL_ZERO_BYTES, stream);
    Args a{};
    for (int i = 0; i < 20; ++i) a.in[i] = (const float*)d_in[i];
    a.out = (float*)d_out; a.ws = (unsigned char*)d_ws; a.pad = 0;
#if MK_ONE_LAUNCH
    a.ph_lo = 0; a.ph_hi = NPHASES; a.one = 1;
    hipLaunchKernelGGL(fwd, dim3(grid), dim3(512), LDS_BYTES, stream, a);
#else
    a.one = 0;
    for (int p = 0; p < NPHASES; ++p) { a.ph_lo = p; a.ph_hi = p + 1; hipLaunchKernelGGL(fwd, dim3(grid), dim3(512), LDS_BYTES, stream, a); }
#endif
}
```

```cpp
#include <hip/hip_runtime.h>
#include <cstdio>
#include <cstdint>

#ifndef INPROJ_BF16_PART
#define INPROJ_BF16_PART 1
#endif
#ifndef MK_ONE_LAUNCH
#define MK_ONE_LAUNCH 1
#endif

#define GAS __attribute__((address_space(1)))
#define LAS __attribute__((address_space(3)))
typedef unsigned short bf16_t;
typedef short bf16x8 __attribute__((ext_vector_type(8)));
typedef float f32x4 __attribute__((ext_vector_type(4)));
typedef float f32x2 __attribute__((ext_vector_type(2)));
typedef unsigned u32x4 __attribute__((ext_vector_type(4)));
typedef unsigned u32x2 __attribute__((ext_vector_type(2)));
typedef int i32x8 __attribute__((ext_vector_type(8)));
typedef int i32x4 __attribute__((ext_vector_type(4)));

constexpr int S = 8192, D = 4096, DEPTH = 4, CW = 768, AW = 1536, KVW = 256, NIN = 18176, FF = 16384, MIXW = 3072, NG = 3 * D;
constexpr int NQH = 24, HD = 64;
constexpr float LN_EPS = 1e-5f;
constexpr float ALPHA = 1.681792830507429f;
constexpr float L2E = 1.4426950408889634f;
constexpr float QSCALE = 0.125f * L2E;
constexpr int NBF = 5888, NBF2 = 2304;
constexpr int NBF_OLD_UNUSED = 0;
constexpr int NBFX = 5888;
constexpr float XQ_SCALE = 16.f, WQ_SCALE = 1024.f, GQ_DESCALE = 1.f / (16.f * 1024.f);

constexpr size_t MiB = 1u << 20;
constexpr size_t WS_CTL = 0, CTL_ZERO_BYTES = 1 * MiB;
constexpr size_t WS_BIASP = 1 * MiB;
constexpr size_t WS_XB = 2 * MiB;
constexpr size_t WS_X1B = WS_XB + 64 * MiB;
constexpr size_t WS_XF = WS_X1B + 64 * MiB;
constexpr size_t WS_X1F = WS_XF + 128 * MiB;
constexpr size_t WS_V = WS_X1F + 128 * MiB;
constexpr size_t WS_U = WS_V + 128 * MiB;
constexpr size_t WS_CX = WS_U + 12 * MiB;
constexpr size_t WS_SB = WS_CX + 12 * MiB;
constexpr size_t WS_Q = WS_SB + 12 * MiB;
constexpr size_t WS_K = WS_Q + 24 * MiB;
constexpr size_t WS_VT = WS_K + 4 * MiB;
constexpr size_t WS_SG = WS_VT + 4 * MiB;
constexpr size_t WS_Y = WS_SG + 192 * MiB;
constexpr size_t WS_MG = WS_Y + 48 * MiB;
constexpr size_t WS_HID = WS_MG + 64 * MiB;
constexpr size_t WS_W = WS_HID + 256 * MiB;
constexpr size_t W_IN_B = (size_t)NIN * D * 2, W_B_B = (size_t)D * MIXW * 2, W_O_B = (size_t)D * D * 2, W_1_B = (size_t)FF * D * 2, W_2_B = (size_t)D * FF * 2;
constexpr size_t W_LAYER_B = W_IN_B + W_B_B + W_O_B + W_1_B + W_2_B;
constexpr size_t WS_WG = WS_W + DEPTH * W_LAYER_B;
constexpr size_t W_G_B = (size_t)NIN * D;
constexpr size_t WS_XQ = WS_WG + DEPTH * W_G_B;
constexpr size_t WS_END = WS_XQ + (size_t)S * D;
constexpr int CW_BAR = 4096;

constexpr int RING_BYTES = 131072;
constexpr int MISC_OFF = RING_BYTES + 320;
constexpr int LDS_BYTES = 147456;

#define LDS_WAIT() asm volatile("s_waitcnt lgkmcnt(0)" ::: "memory")
#define VM_WAIT() asm volatile("s_waitcnt vmcnt(0)" ::: "memory")

typedef __bf16 bf16x2_t __attribute__((ext_vector_type(2)));
__device__ __forceinline__ unsigned cvt_pk_bf16(float lo, float hi) { const f32x2 v = {lo, hi}; const bf16x2_t b = __builtin_convertvector(v, bf16x2_t); return __builtin_bit_cast(unsigned, b); }
__device__ __forceinline__ float bf_lo(unsigned u) { return __builtin_bit_cast(float, u << 16); }
__device__ __forceinline__ float bf_hi(unsigned u) { return __builtin_bit_cast(float, u & 0xffff0000u); }
__device__ __forceinline__ float sigmoidf_fast(float x) { return __builtin_amdgcn_rcpf(1.f + __builtin_amdgcn_exp2f(-L2E * x)); }
__device__ __forceinline__ float wave_sum(float v) {
#pragma unroll
    for (int o = 1; o < 64; o <<= 1) v += __shfl_xor(v, o);
    return v;
}

#define XB_TMO      128
#define XB_XCNT(j)  (256  + 64 * (j))
#define XB_XSUB(j)  (1280 + 64 * (j))
#define XB_XGEN(j)  (2304 + 64 * (j))
#define XB_TOP      3328
#define XB_TOPGEN   3392
#define XCD_BAR_WORDS 3456
#define XB_SPIN_CAP (1u << 20)

__device__ __forceinline__ unsigned xb_ld(unsigned* p)              { return __hip_atomic_load(p, __ATOMIC_RELAXED, __HIP_MEMORY_SCOPE_AGENT); }
__device__ __forceinline__ unsigned xb_add(unsigned* p, unsigned v) { return __hip_atomic_fetch_add(p, v, __ATOMIC_RELAXED, __HIP_MEMORY_SCOPE_AGENT); }
__device__ __forceinline__ unsigned xb_xcc_id() { return (unsigned)__builtin_amdgcn_s_getreg((3 << 11) | 20) & 0xFu; }
#define XB_SPIN(cond, bar) do { unsigned _sp = 0; while (cond) { __builtin_amdgcn_s_sleep(1); \
    if ((++_sp & 255u) == 0u) { if (xb_ld(&(bar)[XB_TMO])) break; if (_sp > XB_SPIN_CAP) { atomicAdd(&(bar)[XB_TMO], 1u); break; } } } } while (0)

struct XcdBarrier { unsigned* bar; unsigned x; volatile LAS unsigned* st; };

__device__ __forceinline__ XcdBarrier xcd_barrier_post(unsigned* bar, volatile LAS unsigned* st) {
    XcdBarrier b; b.bar = bar; b.x = xb_xcc_id(); b.st = st;
    if (threadIdx.x == 0) (void)xb_add(&bar[XB_XCNT(b.x)], 1u);
    return b;
}
__device__ __forceinline__ void xcd_barrier_complete(unsigned* bar, unsigned x, unsigned& nloc, unsigned& nx) {
    const unsigned G = gridDim.x * gridDim.y * gridDim.z;
    unsigned sum, cnt, mine, sp = 0u;
    for (;;) {
        sum = 0u; cnt = 0u; mine = 0u;
#pragma unroll
        for (unsigned j = 0; j < 16; ++j) { const unsigned c = xb_ld(&bar[XB_XCNT(j)]); sum += c; cnt += (c > 0u) ? 1u : 0u; mine = (j == x) ? c : mine; }
        if (sum == G) break;
        __builtin_amdgcn_s_sleep(1);
        if ((++sp & 255u) == 0u) { if (xb_ld(&bar[XB_TMO])) break; if (sp > XB_SPIN_CAP) { atomicAdd(&bar[XB_TMO], 1u); break; } }
    }
    nloc = mine > 0u ? mine : 1u; nx = cnt > 0u ? cnt : 1u;
}
__device__ __forceinline__ void xcd_barrier(const XcdBarrier& b) {
    asm volatile("s_waitcnt vmcnt(0)" ::: "memory");
    __syncthreads();
    if (threadIdx.x == 0) {
        unsigned* bar = b.bar;
        __builtin_amdgcn_s_waitcnt(0);
        unsigned nloc = b.st[0], nx = b.st[1];
        if (nloc == 0u) { xcd_barrier_complete(bar, b.x, nloc, nx); b.st[0] = nloc; b.st[1] = nx; }
        const unsigned old = xb_add(&bar[XB_XSUB(b.x)], 1u);
        const unsigned gen = old / nloc;
        if (old + 1u == (gen + 1u) * nloc) {
            __builtin_amdgcn_fence(__ATOMIC_RELEASE, "agent");
            asm volatile("s_waitcnt vmcnt(0)" ::: "memory");
            const unsigned og = xb_add(&bar[XB_TOP], 1u);
            const unsigned tg = og / nx;
            if (og + 1u == (tg + 1u) * nx) xb_add(&bar[XB_TOPGEN], 1u);
            else XB_SPIN(xb_ld(&bar[XB_TOPGEN]) == tg, bar);
            __builtin_amdgcn_fence(__ATOMIC_ACQUIRE, "agent");
            xb_add(&bar[XB_XGEN(b.x)], 1u);
            asm volatile("s_waitcnt vmcnt(0)" ::: "memory");
        } else {
            XB_SPIN(xb_ld(&bar[XB_XGEN(b.x)]) == gen, bar);
            __builtin_amdgcn_fence(__ATOMIC_ACQUIRE, "agent");
            asm volatile("s_waitcnt vmcnt(0)" ::: "memory");
        }
    }
    __syncthreads();
}

namespace pg8 {
constexpr int BM = 256, BK = 64, HALF = 128, HTB = HALF * BK * 2, NXCD = 8, WGM = 8;
__host__ __device__ __forceinline__ int lds_byte(int r, int c) { const int st = (r >> 4) * 2 + (c >> 5), rr = r & 15, cc = c & 31, ob = rr * 64 + cc * 2; return st * 1024 + (ob ^ (((ob >> 9) & 1) << 5)); }
__host__ __device__ __forceinline__ void stage_rc(int b, int& R, int& C) { const int st = b / 1024, sb = b % 1024, swz = sb ^ (((sb >> 9) & 1) << 5); R = (st >> 1) * 16 + swz / 64; C = (st & 1) * 32 + (swz % 64) / 2; }
__host__ __device__ __forceinline__ int perm32(int rho) { const int n = rho >> 4, i = rho & 15; return 8 * (i >> 2) + 4 * n + (i & 3); }

struct Unit { int pm, pn; };
struct Gemm { const void* A; const void* Bt; int ldaB, ldbB, nt; };

struct StaticOrder {
    int nM, nN, nwg, G, c;
    __device__ void init(int M, int N, int G_, int c_) { nM = M / BM; nN = N / BM; nwg = nM * nN; G = G_; c = c_; }
    __device__ bool next(int i, Unit& u) const {
        const long L = (long)i * G + c; if (L >= nwg) return false;
        int wgid = (int)L; { const int q = nwg / NXCD, r = nwg % NXCD, xcd = wgid % NXCD, off = wgid / NXCD; wgid = (xcd < r ? xcd * (q + 1) : r * (q + 1) + (xcd - r) * q) + off; }
        const int nig = WGM * nN, gid = wgid / nig, fm = gid * WGM, gsz = (nM - fm) < WGM ? (nM - fm) : WGM;
        u.pm = fm + ((wgid % nig) % gsz); u.pn = (wgid % nig) / gsz; return true;
    }
};

struct BalancedOrder {
    int nM, nN, nwg, G, c, R0, C0;
    __device__ void init(int M, int N, int G_, int c_, int R0_, int C0_) { nM = M / BM; nN = N / BM; nwg = nM * nN; G = G_; c = c_; R0 = R0_; C0 = C0_; }
    __device__ bool next(int i, Unit& u) const {
        long L;
        if (i < R0) L = (long)i * G + c; else { if (c < C0) return false; L = (long)R0 * G + (long)(i - R0) * (G - C0) + (c - C0); }
        if (L >= nwg) return false;
        int wgid = (int)L; { const int q = nwg / NXCD, r = nwg % NXCD, xcd = wgid % NXCD, off = wgid / NXCD; wgid = (xcd < r ? xcd * (q + 1) : r * (q + 1) + (xcd - r) * q) + off; }
        const int nig = WGM * nN, gid = wgid / nig, fm = gid * WGM, gsz = (nM - fm) < WGM ? (nM - fm) : WGM;
        u.pm = fm + ((wgid % nig) % gsz); u.pn = (wgid % nig) / gsz; return true;
    }
};

template <class Epi, bool MID, bool FP8 = false, class Sched = StaticOrder>
__device__ __forceinline__ void gemm_phase(LAS unsigned char* lds, const Gemm g, const Sched& S, const Epi& E, const int tid) {
    const int wid = __builtin_amdgcn_readfirstlane(tid >> 6), lane = tid & 63, wr = wid >> 2, wc = wid & 3, fr = lane & 15, fq = lane >> 4;
    const int nt = g.nt;
    unsigned voffA, voffB;
    { int R, C; stage_rc(tid * 16, R, C); const int Rb = (R & ~31) + perm32(R & 31); voffA = (unsigned)(R * g.ldaB + C * 2); voffB = (unsigned)(Rb * g.ldbB + C * 2); }
    const size_t p2A = (size_t)64 * g.ldaB, p2B = (size_t)64 * g.ldbB;
    const size_t kstep = (size_t)(BK * 2);
    const size_t hstepA = (size_t)HALF * g.ldaB, hstepB = (size_t)HALF * g.ldbB;
    const size_t tstepA = 2 * hstepA, tstepB = 2 * hstepB;
    const unsigned ldsw = (unsigned)wid * 1024u;
    constexpr int KOFF = FP8 ? 16 : 1024;
    const int aoff = lds_byte(wr * 64 + fr, FP8 ? fq * 16 : fq * 8), boff = lds_byte(wc * 32 + fr, FP8 ? fq * 16 : fq * 8);
#define PG8_SA(b, h) (((b) * 2 + (h)) * HTB)
#define PG8_SB(b, h) ((4 + (b) * 2 + (h)) * HTB)
#define PG8_STAGE(bufoff, gbase, X) do { _Pragma("unroll") for (int _i = 0; _i < 2; ++_i) \
        __builtin_amdgcn_global_load_lds((const unsigned*)((const char*)(gbase) + (_i ? p2##X : (size_t)0) + voff##X), (LAS unsigned*)(lds + (bufoff) + ldsw + _i * 8192), 16, 0, 0); } while (0)
#define PG8_LD32(p) __builtin_shufflevector(*(const LAS i32x4*)(p), *(const LAS i32x4*)((p) + 16), 0, 1, 2, 3, 4, 5, 6, 7)
#define PG8_LDA(dst, b, h) do { _Pragma("unroll") for (int m = 0; m < 4; ++m) { if constexpr (FP8) dst##8[m] = PG8_LD32(lds + PG8_SA(b, h) + aoff + m * 2048); else { _Pragma("unroll") for (int k = 0; k < 2; ++k) dst[m][k] = *(const LAS bf16x8*)(lds + PG8_SA(b, h) + aoff + m * 2048 + k * KOFF); } } } while (0)
#define PG8_LDB(dst, b, h) do { _Pragma("unroll") for (int n = 0; n < 2; ++n) { if constexpr (FP8) dst##8[n] = PG8_LD32(lds + PG8_SB(b, h) + boff + n * 2048); else { _Pragma("unroll") for (int k = 0; k < 2; ++k) dst[n][k] = *(const LAS bf16x8*)(lds + PG8_SB(b, h) + boff + n * 2048 + k * KOFF); } } } while (0)
#define PG8_CAT8(x) __builtin_shufflevector(__builtin_bit_cast(i32x4, (x)[0]), __builtin_bit_cast(i32x4, (x)[1]), 0, 1, 2, 3, 4, 5, 6, 7)
#define PG8_MMA(ai, bj, At, Bt) do { __builtin_amdgcn_s_setprio(1); _Pragma("unroll") for (int m = 0; m < 4; ++m) _Pragma("unroll") for (int n = 0; n < 2; ++n) { \
        if constexpr (FP8) asm volatile("v_mfma_scale_f32_16x16x128_f8f6f4 %0, %1, %2, %0, %3, %3 op_sel_hi:[0,0,0]" : "+v"(acc[ai][bj][m][n]) : "v"(Bt##8[n]), "v"(At##8[m]), "v"(sc127)); \
        else { _Pragma("unroll") for (int k = 0; k < 2; ++k) acc[ai][bj][m][n] = __builtin_amdgcn_mfma_f32_16x16x32_bf16(Bt[n][k], At[m][k], acc[ai][bj][m][n], 0, 0, 0); } } \
        __builtin_amdgcn_s_setprio(0); } while (0)
#define PG8_WAIT_V(n) asm volatile("s_waitcnt vmcnt(" #n ")" ::: "memory")
#define PG8_WAIT_L(n) asm volatile("s_waitcnt lgkmcnt(" #n ")" ::: "memory")
#define PG8_BAR __builtin_amdgcn_s_barrier()
#define PG8_SCHED __builtin_amdgcn_sched_barrier(0)
    Unit cur, nxt; int ui = 0;
    if (!S.next(0, cur)) return;
    f32x4 acc[2][2][4][2];
#pragma unroll
    for (int a = 0; a < 2; ++a)
#pragma unroll
        for (int b = 0; b < 2; ++b)
#pragma unroll
            for (int m = 0; m < 4; ++m)
#pragma unroll
                for (int n = 0; n < 2; ++n) acc[a][b][m][n] = (f32x4){0.f, 0.f, 0.f, 0.f};
    int sc127 = 127; asm volatile("" : "+v"(sc127));
    bf16x8 At[4][2], B0[2][2], B1[2][2]; i32x8 At8[4], B08[2], B18[2]; (void)At; (void)B0; (void)B1; (void)At8; (void)B08; (void)B18;
    const char* cA = (const char*)g.A + (size_t)cur.pm * tstepA; const char* cB = (const char*)g.Bt + (size_t)cur.pn * tstepB;
    PG8_STAGE(PG8_SB(0, 0), cB, B); PG8_STAGE(PG8_SB(0, 1), cB + hstepB, B); PG8_STAGE(PG8_SA(0, 0), cA, A); PG8_STAGE(PG8_SA(0, 1), cA + hstepA, A);
    if (wr == 1) PG8_BAR;
    PG8_WAIT_V(2); PG8_BAR;
    PG8_STAGE(PG8_SB(1, 0), cB + kstep, B); PG8_STAGE(PG8_SA(1, 0), cA + kstep, A); PG8_STAGE(PG8_SB(1, 1), cB + hstepB + kstep, B);
    PG8_WAIT_V(6); PG8_BAR;
    for (;;) {
        const bool has_next = S.next(ui + 1, nxt);
        const char* nA = has_next ? (const char*)g.A + (size_t)nxt.pm * tstepA : cA; const char* nB = has_next ? (const char*)g.Bt + (size_t)nxt.pn * tstepB : cB;
        for (int t = 0; t < nt; t += 2) {
            const bool last = (t == nt - 2);
            const char* a1 = cA + (size_t)(t + 1) * kstep;
            const char* a2 = last ? nA : cA + (size_t)(t + 2) * kstep; const char* b2 = last ? nB : cB + (size_t)(t + 2) * kstep;
            const char* a3 = a2 + kstep; const char* b3 = b2 + kstep;
            PG8_LDB(B0, 0, 0); PG8_LDB(B1, 0, 1); PG8_SCHED; PG8_LDA(At, 0, 0); PG8_STAGE(PG8_SA(1, 1), a1 + hstepA, A);
            PG8_WAIT_V(8); PG8_WAIT_L(0); PG8_BAR; PG8_MMA(0, 0, At, B0); PG8_MMA(0, 1, At, B1); PG8_BAR; PG8_SCHED;
            PG8_LDA(At, 0, 1); PG8_STAGE(PG8_SB(0, 0), b2, B); PG8_STAGE(PG8_SB(0, 1), b2 + hstepB, B); PG8_STAGE(PG8_SA(0, 0), a2, A);
            PG8_WAIT_V(8); PG8_WAIT_L(0); PG8_BAR; PG8_MMA(1, 0, At, B0); PG8_MMA(1, 1, At, B1); PG8_BAR; PG8_SCHED;
            PG8_LDB(B0, 1, 0); PG8_LDB(B1, 1, 1); PG8_SCHED; PG8_LDA(At, 1, 0); PG8_STAGE(PG8_SA(0, 1), a2 + hstepA, A);
            PG8_WAIT_V(8); PG8_WAIT_L(0); PG8_BAR; PG8_MMA(0, 0, At, B0); PG8_MMA(0, 1, At, B1); PG8_BAR; PG8_SCHED;
            PG8_LDA(At, 1, 1); PG8_STAGE(PG8_SB(1, 0), b3, B); PG8_STAGE(PG8_SB(1, 1), b3 + hstepB, B); PG8_STAGE(PG8_SA(1, 0), a3, A);
            PG8_WAIT_V(8); PG8_WAIT_L(0); PG8_BAR; PG8_MMA(1, 0, At, B0); PG8_MMA(1, 1, At, B1); PG8_BAR; PG8_SCHED;
            if constexpr (MID) { if (t + 2 == Epi::MID1 || t + 2 == Epi::MID2) { E.mid(acc, cur, (t + 2 == Epi::MID1) ? 0 : 1, wr, wc, fr, fq); PG8_SCHED; } }
        }
        if (wr == 0) PG8_BAR;
        if constexpr (FP8) asm volatile("s_nop 15\n\ts_nop 15" ::: "memory");
        E(acc, cur, wr, wc, fr, fq);
        if (!has_next) break;
#pragma unroll
        for (int a = 0; a < 2; ++a)
#pragma unroll
            for (int b = 0; b < 2; ++b)
#pragma unroll
                for (int m = 0; m < 4; ++m)
#pragma unroll
                    for (int n = 0; n < 2; ++n) acc[a][b][m][n] = (f32x4){0.f, 0.f, 0.f, 0.f};
        cur = nxt; cA = nA; cB = nB; ++ui;
        if (wr == 1) PG8_BAR;
    }
    PG8_WAIT_V(0);
    PG8_BAR;
#undef PG8_SA
#undef PG8_SB
#undef PG8_STAGE
#undef PG8_LDA
#undef PG8_LD32
#undef PG8_LDB
#undef PG8_MMA
#undef PG8_CAT8
#undef PG8_WAIT_V
#undef PG8_WAIT_L
#undef PG8_BAR
#undef PG8_SCHED
}

__device__ __forceinline__ u32x4 pack8(f32x4 a, f32x4 b) { u32x4 w; w.x = cvt_pk_bf16(a[0], a[1]); w.y = cvt_pk_bf16(a[2], a[3]); w.z = cvt_pk_bf16(b[0], b[1]); w.w = cvt_pk_bf16(b[2], b[3]); return w; }
__device__ __forceinline__ f32x4 sig4(f32x4 v) { f32x4 r; r[0] = sigmoidf_fast(v[0]); r[1] = sigmoidf_fast(v[1]); r[2] = sigmoidf_fast(v[2]); r[3] = sigmoidf_fast(v[3]); return r; }
__device__ __forceinline__ f32x4 clamp4(f32x4 v, float lo, float hi) { f32x4 r; for (int i = 0; i < 4; ++i) r[i] = fminf(fmaxf(v[i], lo), hi); return r; }

struct EpiInProj {
    const float* bias;
    bf16_t *U, *CX, *SBb, *Q, *Kb, *VT, *SG; float ds; int t0;
    __device__ __forceinline__ void operator()(const f32x4 (&acc)[2][2][4][2], const Unit& u, int wr, int wc, int fr, int fq) const {
        const int t = u.pn + t0, row0 = u.pm * BM + wr * 64 + fr, cw = wc * 32 + 8 * fq;
        f32x4 bv[2][2];
#define LOAD_BV() _Pragma("unroll") for (int bj = 0; bj < 2; ++bj) _Pragma("unroll") for (int n = 0; n < 2; ++n) bv[bj][n] = *(const f32x4*)(bias + t * BM + bj * HALF + cw + 4 * n)
        if (t < 6 || (t >= 9 && t < 15)) {
            LOAD_BV();
            const bool glu = t >= 9; bf16_t* O = (glu ? U : CX) + (glu ? t - 9 : t) * HALF + cw;
#pragma unroll
            for (int ai = 0; ai < 2; ++ai)
#pragma unroll
                for (int m = 0; m < 4; ++m) {
                    const int row = row0 + ai * HALF + m * 16;
                    f32x4 a0 = acc[ai][0][m][0] * ds + bv[0][0], a1 = acc[ai][0][m][1] * ds + bv[0][1], g0 = acc[ai][1][m][0] * ds + bv[1][0], g1 = acc[ai][1][m][1] * ds + bv[1][1];
                    if (glu) { g0 = sig4(g0); g1 = sig4(g1); }
                    *(u32x4*)(O + (size_t)row * CW) = pack8(a0 * g0, a1 * g1);
                }
        } else if (t == 22) {
            LOAD_BV();
#pragma unroll
            for (int ai = 0; ai < 2; ++ai)
#pragma unroll
                for (int m = 0; m < 4; ++m) {
                    const int row = row0 + ai * HALF + m * 16;
#pragma unroll
                    for (int bj = 0; bj < 2; ++bj) {
                        const u32x4 w = pack8(acc[ai][bj][m][0] * ds + bv[bj][0], acc[ai][bj][m][1] * ds + bv[bj][1]);
                        bf16_t* o = VT + (size_t)(bj * HALF + cw) * S + row;
                        o[0 * (size_t)S] = (bf16_t)(w.x & 0xffffu); o[1 * (size_t)S] = (bf16_t)(w.x >> 16); o[2 * (size_t)S] = (bf16_t)(w.y & 0xffffu); o[3 * (size_t)S] = (bf16_t)(w.y >> 16);
                        o[4 * (size_t)S] = (bf16_t)(w.z & 0xffffu); o[5 * (size_t)S] = (bf16_t)(w.z >> 16); o[6 * (size_t)S] = (bf16_t)(w.w & 0xffffu); o[7 * (size_t)S] = (bf16_t)(w.w >> 16);
                    }
                }
        } else {
            bf16_t* O; int ld; float sc = 1.f; bool sg = false;
            if (t < 9) { O = SBb + (t - 6) * BM; ld = CW; }
            else if (t < 21) { O = Q + (t - 15) * BM; ld = AW; sc = QSCALE; }
            else if (t == 21) { O = Kb; ld = KVW; }
            else { O = SG + (t - 23) * BM; ld = NG; sg = true; }
            O += cw;
            LOAD_BV();
#pragma unroll
            for (int ai = 0; ai < 2; ++ai)
#pragma unroll
                for (int m = 0; m < 4; ++m) {
                    const int row = row0 + ai * HALF + m * 16;
#pragma unroll
                    for (int bj = 0; bj < 2; ++bj) {
                        f32x4 v0 = acc[ai][bj][m][0] * ds + bv[bj][0], v1 = acc[ai][bj][m][1] * ds + bv[bj][1];
                        if (sg) { v0 = sig4(clamp4(v0, -60.f, 60.f)); v1 = sig4(clamp4(v1, -60.f, 60.f)); } else { v0 = v0 * sc; v1 = v1 * sc; }
                        *(u32x4*)(O + (size_t)row * ld + bj * HALF) = pack8(v0, v1);
                    }
                }
        }
    }
};

struct EpiGates {
    const float* bias; bf16_t* SG;
    __device__ __forceinline__ void operator()(const f32x4 (&acc)[2][2][4][2], const Unit& u, int wr, int wc, int fr, int fq) const {
        const int row0 = u.pm * BM + wr * 64 + fr, col0 = u.pn * BM + wc * 32 + 8 * fq;
        f32x4 bv[2][2];
#pragma unroll
        for (int bj = 0; bj < 2; ++bj)
#pragma unroll
            for (int n = 0; n < 2; ++n) bv[bj][n] = *(const f32x4*)(bias + col0 + bj * HALF + 4 * n);
#pragma unroll
        for (int ai = 0; ai < 2; ++ai)
#pragma unroll
            for (int m = 0; m < 4; ++m)
#pragma unroll
                for (int bj = 0; bj < 2; ++bj) {
                    const f32x4 v0 = sig4(clamp4(acc[ai][bj][m][0] * GQ_DESCALE + bv[bj][0], -60.f, 60.f)), v1 = sig4(clamp4(acc[ai][bj][m][1] * GQ_DESCALE + bv[bj][1], -60.f, 60.f));
                    *(u32x4*)(SG + (size_t)(row0 + ai * HALF + m * 16) * NG + col0 + bj * HALF) = pack8(v0, v1);
                }
    }
};

__device__ __forceinline__ f32x4 up_lo(u32x2 p) { return (f32x4){bf_lo(p.x), bf_hi(p.x), bf_lo(p.y), bf_hi(p.y)}; }
__device__ __forceinline__ f32x4 rcp4(f32x4 v) { f32x4 r; for (int i = 0; i < 4; ++i) r[i] = __builtin_amdgcn_rcpf(v[i]); return r; }

struct EpiMerge {
    static constexpr int MID1 = CW / BK, MID2 = 2 * CW / BK;
    const bf16_t* SG; bf16_t* MG;
    __device__ __forceinline__ void mid(f32x4 (&acc)[2][2][4][2], const Unit& u, int which, int wr, int wc, int fr, int fq) const {
        const unsigned loff = (unsigned)(fr * NG + 8 * fq) * 2u;
        const char* nb = (const char*)SG + ((size_t)(u.pm * BM + wr * 64) * NG + (size_t)which * D + u.pn * BM + wc * 32) * 2;
#pragma unroll
        for (int ai = 0; ai < 2; ++ai)
#pragma unroll
            for (int bj = 0; bj < 2; ++bj) {
                u32x4 nv[4], dv[4];
#pragma unroll
                for (int m = 0; m < 4; ++m) { const char* p = nb + ((size_t)(ai * HALF + m * 16) * NG + bj * HALF) * 2; nv[m] = *(const u32x4*)(p + loff); dv[m] = *(const u32x4*)(p + (size_t)D * 2 + loff); }
#pragma unroll
                for (int m = 0; m < 4; ++m) {
                    const f32x4 r0 = up_lo((u32x2){nv[m].x, nv[m].y}) * rcp4(up_lo((u32x2){dv[m].x, dv[m].y}));
                    const f32x4 r1 = up_lo((u32x2){nv[m].z, nv[m].w}) * rcp4(up_lo((u32x2){dv[m].z, dv[m].w}));
                    acc[ai][bj][m][0] = acc[ai][bj][m][0] * r0; acc[ai][bj][m][1] = acc[ai][bj][m][1] * r1;
                }
                __builtin_amdgcn_sched_barrier(0);
            }
    }
    __device__ __forceinline__ void operator()(const f32x4 (&acc)[2][2][4][2], const Unit& u, int wr, int wc, int fr, int fq) const {
        const unsigned loff = (unsigned)(fr * NG + 8 * fq) * 2u, loffo = (unsigned)(fr * D + 8 * fq) * 2u;
        const char* gb = (const char*)SG + ((size_t)(u.pm * BM + wr * 64) * NG + (size_t)2 * D + u.pn * BM + wc * 32) * 2;
        char* ob = (char*)MG + ((size_t)(u.pm * BM + wr * 64) * D + u.pn * BM + wc * 32) * 2;
#pragma unroll
        for (int ai = 0; ai < 2; ++ai)
#pragma unroll
            for (int bj = 0; bj < 2; ++bj) {
                u32x4 gv[4];
#pragma unroll
                for (int m = 0; m < 4; ++m) gv[m] = *(const u32x4*)(gb + ((size_t)(ai * HALF + m * 16) * NG + bj * HALF) * 2 + loff);
#pragma unroll
                for (int m = 0; m < 4; ++m) {
                    const f32x4 v0 = acc[ai][bj][m][0] * up_lo((u32x2){gv[m].x, gv[m].y}), v1 = acc[ai][bj][m][1] * up_lo((u32x2){gv[m].z, gv[m].w});
                    *(u32x4*)(ob + ((size_t)(ai * HALF + m * 16) * D + bj * HALF) * 2 + loffo) = pack8(v0, v1);
                }
                __builtin_amdgcn_sched_barrier(0);
            }
    }
};

struct EpiResid {
    const float* R; const float* bias; float* O;
    __device__ __forceinline__ void operator()(const f32x4 (&acc)[2][2][4][2], const Unit& u, int wr, int wc, int fr, int fq) const {
        const int row0 = u.pm * BM + wr * 64 + fr, col0 = u.pn * BM + wc * 32 + 8 * fq;
        f32x4 bv[2][2];
#pragma unroll
        for (int bj = 0; bj < 2; ++bj)
#pragma unroll
            for (int n = 0; n < 2; ++n) bv[bj][n] = *(const f32x4*)(bias + col0 + bj * HALF + 4 * n);
#pragma unroll
        for (int ai = 0; ai < 2; ++ai) {
            f32x4 rv[4][2][2];
#pragma unroll
            for (int m = 0; m < 4; ++m)
#pragma unroll
                for (int bj = 0; bj < 2; ++bj)
#pragma unroll
                    for (int n = 0; n < 2; ++n) rv[m][bj][n] = *(const f32x4*)(R + (size_t)(row0 + ai * HALF + m * 16) * D + col0 + bj * HALF + 4 * n);
#pragma unroll
            for (int m = 0; m < 4; ++m)
#pragma unroll
                for (int bj = 0; bj < 2; ++bj)
#pragma unroll
                    for (int n = 0; n < 2; ++n) *(f32x4*)(O + (size_t)(row0 + ai * HALF + m * 16) * D + col0 + bj * HALF + 4 * n) = rv[m][bj][n] * ALPHA + acc[ai][bj][m][n] + bv[bj][n];
            __builtin_amdgcn_sched_barrier(0);
        }
    }
};

struct EpiRelu2 {
    const float* bias; bf16_t* O;
    __device__ __forceinline__ void operator()(const f32x4 (&acc)[2][2][4][2], const Unit& u, int wr, int wc, int fr, int fq) const {
        const int row0 = u.pm * BM + wr * 64 + fr, col0 = u.pn * BM + wc * 32 + 8 * fq;
        f32x4 bv[2][2];
#pragma unroll
        for (int bj = 0; bj < 2; ++bj)
#pragma unroll
            for (int n = 0; n < 2; ++n) bv[bj][n] = *(const f32x4*)(bias + col0 + bj * HALF + 4 * n);
#pragma unroll
        for (int ai = 0; ai < 2; ++ai)
#pragma unroll
            for (int m = 0; m < 4; ++m)
#pragma unroll
                for (int bj = 0; bj < 2; ++bj) {
                    f32x4 v0 = acc[ai][bj][m][0] + bv[bj][0], v1 = acc[ai][bj][m][1] + bv[bj][1];
#pragma unroll
                    for (int i = 0; i < 4; ++i) { v0[i] = fmaxf(v0[i], 0.f); v0[i] *= v0[i]; v1[i] = fmaxf(v1[i], 0.f); v1[i] *= v1[i]; }
                    *(u32x4*)(O + (size_t)(row0 + ai * HALF + m * 16) * FF + col0 + bj * HALF) = pack8(v0, v1);
                }
    }
};
}

__host__ __device__ __forceinline__ int inproj_dst_row(int o) {
    if (o < 768) return 256 * (9 + o / 128) + (o % 128);
    if (o < 1536) { const int c = o - 768; return 256 * (9 + c / 128) + 128 + (c % 128); }
    if (o < 2304) return 6 * 256 + (o - 1536);
    if (o < 3072) { const int c = o - 2304; return 256 * (c / 128) + (c % 128); }
    if (o < 3840) { const int c = o - 3072; return 256 * (c / 128) + 128 + (c % 128); }
    return o;
}

__device__ __forceinline__ void transpose_item(const float* __restrict__ W, int N, bf16_t* WT, int K, int k0, int n0, int dst_row, LAS float* scr, int lane) {
    const int kr = lane >> 3, nc = lane & 7;
    f32x4 v[8];
#pragma unroll
    for (int i = 0; i < 8; ++i) v[i] = *(const f32x4*)(W + (size_t)(k0 + 8 * i + kr) * N + n0 + 4 * nc);
#pragma unroll
    for (int i = 0; i < 8; ++i) { LAS float* s = scr + (8 * i + kr) * 33 + 4 * nc; s[0] = v[i][0]; s[1] = v[i][1]; s[2] = v[i][2]; s[3] = v[i][3]; }
    LDS_WAIT();
    const int c = lane & 7;
#pragma unroll
    for (int j = 0; j < 4; ++j) { const int n = (lane >> 3) + 8 * j; const LAS float* s = scr + (8 * c) * 33 + n;
        u32x4 o; o.x = cvt_pk_bf16(s[0 * 33], s[1 * 33]); o.y = cvt_pk_bf16(s[2 * 33], s[3 * 33]); o.z = cvt_pk_bf16(s[4 * 33], s[5 * 33]); o.w = cvt_pk_bf16(s[6 * 33], s[7 * 33]);
        *(u32x4*)(WT + (size_t)(dst_row + n) * K + k0 + 8 * c) = o; }
    LDS_WAIT();
}

__device__ __forceinline__ unsigned pk4_fp8(float a, float b, float c, float d) { unsigned w = 0u; w = __builtin_amdgcn_cvt_pk_fp8_f32(a, b, w, false); w = __builtin_amdgcn_cvt_pk_fp8_f32(c, d, w, true); return w; }
__device__ __forceinline__ void transpose_item_fp8(const float* __restrict__ W, int N, unsigned char* WT8, int K, int k0, int n0, int dst_row, LAS float* scr, int lane) {
    const int kr = lane >> 3, nc = lane & 7;
    f32x4 v[8];
#pragma unroll
    for (int i = 0; i < 8; ++i) v[i] = *(const f32x4*)(W + (size_t)(k0 + 8 * i + kr) * N + n0 + 4 * nc);
#pragma unroll
    for (int i = 0; i < 8; ++i) { LAS float* s = scr + (8 * i + kr) * 33 + 4 * nc; s[0] = v[i][0] * WQ_SCALE; s[1] = v[i][1] * WQ_SCALE; s[2] = v[i][2] * WQ_SCALE; s[3] = v[i][3] * WQ_SCALE; }
    LDS_WAIT();
    const int c = lane & 3;
#pragma unroll
    for (int j = 0; j < 2; ++j) { const int n = (lane >> 2) + 16 * j; const LAS float* s = scr + (16 * c) * 33 + n;
        u32x4 o; o.x = pk4_fp8(s[0 * 33], s[1 * 33], s[2 * 33], s[3 * 33]); o.y = pk4_fp8(s[4 * 33], s[5 * 33], s[6 * 33], s[7 * 33]);
        o.z = pk4_fp8(s[8 * 33], s[9 * 33], s[10 * 33], s[11 * 33]); o.w = pk4_fp8(s[12 * 33], s[13 * 33], s[14 * 33], s[15 * 33]);
        *(u32x4*)(WT8 + (size_t)(dst_row + n) * K + k0 + 16 * c) = o; }
    LDS_WAIT();
}

struct LayerW { bf16_t *WinT, *WbT, *WoT, *W1T, *W2T; unsigned char* WgQ; };
__device__ __forceinline__ LayerW layer_w(unsigned char* ws, int l) {
    unsigned char* b = ws + WS_W + (size_t)l * W_LAYER_B; LayerW w;
    w.WgQ = ws + WS_WG + (size_t)l * W_G_B;
    w.WinT = (bf16_t*)b; w.WbT = (bf16_t*)(b + W_IN_B); w.WoT = (bf16_t*)(b + W_IN_B + W_B_B); w.W1T = (bf16_t*)(b + W_IN_B + W_B_B + W_O_B); w.W2T = (bf16_t*)(b + W_IN_B + W_B_B + W_O_B + W_1_B);
    return w;
}

__device__ __forceinline__ void convert_phase(const float* w_in, const float* w_br, const float* w_out, const float* w_1, const float* w_2, const float* b_in, const LayerW& W, float* biasP,
                                              LAS unsigned char* lds, int gw, int NGW, int wave, int lane, int gtid, int NGT) {
    LAS float* scr = (LAS float*)(lds + wave * 16384);
    constexpr int I_IN = (D / 64) * (NIN / 32), I_B = (MIXW / 64) * (D / 32), I_O = (D / 64) * (D / 32), I_1 = (D / 64) * (FF / 32), I_2 = (FF / 64) * (D / 32);
    constexpr int NITEMS = I_IN + I_B + I_O + I_1 + I_2;
    for (int it = gw; it < NITEMS; it += NGW) {
        int r = it;
        if (r < I_IN) { const int nb = r % (NIN / 32), kb = r / (NIN / 32);
            if (INPROJ_BF16_PART && inproj_dst_row(32 * nb) < NBF2) transpose_item(w_in, NIN, W.WinT, D, 64 * kb, 32 * nb, inproj_dst_row(32 * nb), scr, lane);
            else transpose_item_fp8(w_in, NIN, W.WgQ, D, 64 * kb, 32 * nb, inproj_dst_row(32 * nb), scr, lane);
            continue; } r -= I_IN;
        if (r < I_B) { const int nb = r % (D / 32), kb = r / (D / 32); transpose_item(w_br, D, W.WbT, MIXW, 64 * kb, 32 * nb, 32 * nb, scr, lane); continue; } r -= I_B;
        if (r < I_O) { const int nb = r % (D / 32), kb = r / (D / 32); transpose_item(w_out, D, W.WoT, D, 64 * kb, 32 * nb, 32 * nb, scr, lane); continue; } r -= I_O;
        if (r < I_1) { const int nb = r % (FF / 32), kb = r / (FF / 32); transpose_item(w_1, FF, W.W1T, D, 64 * kb, 32 * nb, 32 * nb, scr, lane); continue; } r -= I_1;
        { const int nb = r % (D / 32), kb = r / (D / 32); transpose_item(w_2, D, W.W2T, FF, 64 * kb, 32 * nb, 32 * nb, scr, lane); }
    }
    for (int o = gtid; o < NIN; o += NGT) biasP[inproj_dst_row(o)] = b_in[o];
}

__device__ __forceinline__ void cvt_rows_phase(const float* X, bf16_t* XB, unsigned char* XQ, int gtid, int NGT) {
    for (size_t i = (size_t)gtid; i < (size_t)S * D / 8; i += (size_t)NGT) {
        const f32x4 a = *(const f32x4*)(X + i * 8), b = *(const f32x4*)(X + i * 8 + 4);
        if (INPROJ_BF16_PART) *(u32x4*)(XB + i * 8) = pg8::pack8(a, b);
        *(u32x2*)(XQ + i * 8) = (u32x2){pk4_fp8(a[0] * XQ_SCALE, a[1] * XQ_SCALE, a[2] * XQ_SCALE, a[3] * XQ_SCALE), pk4_fp8(b[0] * XQ_SCALE, b[1] * XQ_SCALE, b[2] * XQ_SCALE, b[3] * XQ_SCALE)};
    }
}

__device__ __forceinline__ void ln_phase(const float* V, const float* g, const float* b, float* OF, bf16_t* OB, unsigned char* OQ, int gw, int NGW, int lane) {
    for (int row = gw; row < S; row += NGW) {
        const f32x4* vr = (const f32x4*)(V + (size_t)row * D) + lane;
        f32x4 v[16]; float s = 0.f;
#pragma unroll
        for (int j = 0; j < 16; ++j) { v[j] = vr[64 * j]; s += (v[j][0] + v[j][1]) + (v[j][2] + v[j][3]); }
        const float mean = wave_sum(s) * (1.f / D); float s2 = 0.f;
#pragma unroll
        for (int j = 0; j < 16; ++j) { v[j] = v[j] - mean; s2 += (v[j][0] * v[j][0] + v[j][1] * v[j][1]) + (v[j][2] * v[j][2] + v[j][3] * v[j][3]); }
        const float rstd = 1.f / sqrtf(wave_sum(s2) * (1.f / D) + LN_EPS);
        f32x4* of = (f32x4*)(OF + (size_t)row * D) + lane; u32x2* ob = (u32x2*)(OB + (size_t)row * D) + lane;
#pragma unroll
        for (int j = 0; j < 16; ++j) {
            const f32x4 gg = ((const f32x4*)g)[64 * j + lane], bb = ((const f32x4*)b)[64 * j + lane];
            const f32x4 y = v[j] * rstd * gg + bb;
            of[64 * j] = y; if (OB) ob[64 * j] = (u32x2){cvt_pk_bf16(y[0], y[1]), cvt_pk_bf16(y[2], y[3])};
            if (OQ) ((unsigned*)(OQ + (size_t)row * D))[64 * j + lane] = pk4_fp8(y[0] * XQ_SCALE, y[1] * XQ_SCALE, y[2] * XQ_SCALE, y[3] * XQ_SCALE);
        }
    }
}

__device__ __forceinline__ void convB_phase(const bf16_t* CX, const bf16_t* SBb, const float* w3, bf16_t* Y, int gtid, int NGT) {
    for (int idx = gtid; idx < S * (CW / 8); idx += NGT) {
        const int t = idx / (CW / 8), c = (idx % (CW / 8)) * 8;
        const u32x4 z = (u32x4){0u, 0u, 0u, 0u};
        const u32x4 x2 = *(const u32x4*)(CX + (size_t)t * CW + c);
        const u32x4 x1 = t >= 1 ? *(const u32x4*)(CX + (size_t)(t - 1) * CW + c) : z;
        const u32x4 x0 = t >= 2 ? *(const u32x4*)(CX + (size_t)(t - 2) * CW + c) : z;
        const u32x4 sb = *(const u32x4*)(SBb + (size_t)t * CW + c);
        float o[8];
#pragma unroll
        for (int e = 0; e < 4; ++e) {
            const f32x2 w0 = *(const f32x2*)(w3 + 0 * CW + c + 2 * e), w1 = *(const f32x2*)(w3 + 1 * CW + c + 2 * e), w2 = *(const f32x2*)(w3 + 2 * CW + c + 2 * e);
            o[2 * e] = bf_lo(sb[e]) * (w0[0] * bf_lo(x0[e]) + w1[0] * bf_lo(x1[e]) + w2[0] * bf_lo(x2[e]));
            o[2 * e + 1] = bf_hi(sb[e]) * (w0[1] * bf_hi(x0[e]) + w1[1] * bf_hi(x1[e]) + w2[1] * bf_hi(x2[e]));
        }
        u32x4 w; w.x = cvt_pk_bf16(o[0], o[1]); w.y = cvt_pk_bf16(o[2], o[3]); w.z = cvt_pk_bf16(o[4], o[5]); w.w = cvt_pk_bf16(o[6], o[7]);
        *(u32x4*)(Y + (size_t)t * MIXW + CW + c) = w;
    }
}

__device__ __forceinline__ void convA_unit(const bf16_t* U, const float* w, const float* cb, const float* g, const float* b, bf16_t* Y, int r0, LAS unsigned char* lds, int tid, int wave, int lane) {
    for (int c = tid; c < 62 * 96; c += 512) { const int rr = c / 96, cc = c % 96, gr = r0 - 30 + rr;
        const u32x4 v = gr >= 0 ? *(const u32x4*)(U + (size_t)gr * CW + cc * 8) : (u32x4){0u, 0u, 0u, 0u};
        *(LAS u32x4*)(lds + rr * 1536 + cc * 16) = v; }
    __syncthreads();
    f32x2 acc[4][6], w0[6], w1[6], w2[6], w3[6];
#pragma unroll
    for (int j = 0; j < 6; ++j) { w1[j] = (f32x2){0.f, 0.f}; w2[j] = w1[j]; w3[j] = w1[j]; w0[j] = w1[j];
#pragma unroll
        for (int r = 0; r < 4; ++r) acc[r][j] = (f32x2){0.f, 0.f}; }
    const LAS unsigned char* lrow = lds + (4 * wave) * 1536 + lane * 4;
#pragma unroll 2
    for (int i = 0; i < 34; ++i) {
#pragma unroll
        for (int j = 0; j < 6; ++j) { w3[j] = w2[j]; w2[j] = w1[j]; w1[j] = w0[j]; w0[j] = (i <= 30) ? *(const f32x2*)(w + (size_t)(i <= 30 ? i : 30) * CW + 2 * lane + 128 * j) : (f32x2){0.f, 0.f}; }
#pragma unroll
        for (int j = 0; j < 6; ++j) {
            const unsigned p = *(const LAS unsigned*)(lrow + i * 1536 + j * 256);
            const f32x2 uu = (f32x2){bf_lo(p), bf_hi(p)};
            acc[0][j] += w0[j] * uu; acc[1][j] += w1[j] * uu; acc[2][j] += w2[j] * uu; acc[3][j] += w3[j] * uu;
        }
    }
#pragma unroll
    for (int r = 0; r < 4; ++r) {
        const int row = r0 + 4 * wave + r; float s = 0.f;
#pragma unroll
        for (int j = 0; j < 6; ++j) { acc[r][j] += *(const f32x2*)(cb + 2 * lane + 128 * j); s += acc[r][j][0] + acc[r][j][1]; }
        const float mean = wave_sum(s) * (1.f / CW); float s2 = 0.f;
#pragma unroll
        for (int j = 0; j < 6; ++j) { acc[r][j] = acc[r][j] - mean; s2 += acc[r][j][0] * acc[r][j][0] + acc[r][j][1] * acc[r][j][1]; }
        const float rstd = 1.f / sqrtf(wave_sum(s2) * (1.f / CW) + LN_EPS);
#pragma unroll
        for (int j = 0; j < 6; ++j) {
            const f32x2 gg = *(const f32x2*)(g + 2 * lane + 128 * j), bb = *(const f32x2*)(b + 2 * lane + 128 * j);
            f32x2 y = acc[r][j] * rstd * gg + bb; y[0] = y[0] * sigmoidf_fast(y[0]); y[1] = y[1] * sigmoidf_fast(y[1]);
            *(unsigned*)(Y + (size_t)row * MIXW + 2 * lane + 128 * j) = cvt_pk_bf16(y[0], y[1]);
        }
    }
    __syncthreads();
}

__device__ __forceinline__ void attn_item(const bf16_t* Q, const bf16_t* Kb, const bf16_t* VT, bf16_t* Y, const float* sinks, int qb, int h, int lane) {
    const int fr = lane & 15, fq = lane >> 4, kvh = h / 6, q0 = qb * 16, kstart = q0 - 144;
    const float slope = (h < 16) ? __builtin_amdgcn_exp2f(-0.5f * (float)(h + 1)) : __builtin_amdgcn_exp2f(-0.25f * (float)(2 * (h - 16) + 1));
    const float slope2 = slope * L2E, sink2 = sinks[h] * L2E;
    const bf16_t* qp = Q + (size_t)(q0 + fr) * AW + h * HD + fq * 8;
    const bf16x8 qf0 = *(const bf16x8*)qp, qf1 = *(const bf16x8*)(qp + 32);
    f32x4 s[10];
#pragma unroll
    for (int kt = 1; kt < 10; ++kt) {
        int key = kstart + kt * 16 + fr; key = key < 0 ? 0 : key;
        const bf16_t* kp = Kb + (size_t)key * KVW + kvh * HD + fq * 8;
        const bf16x8 k0 = *(const bf16x8*)kp, k1 = *(const bf16x8*)(kp + 32);
        f32x4 z = (f32x4){0.f, 0.f, 0.f, 0.f};
        z = __builtin_amdgcn_mfma_f32_16x16x32_bf16(k0, qf0, z, 0, 0, 0);
        z = __builtin_amdgcn_mfma_f32_16x16x32_bf16(k1, qf1, z, 0, 0, 0);
        s[kt] = z;
    }
    const int qpos = q0 + fr; float mx = sink2;
#pragma unroll
    for (int kt = 1; kt < 10; ++kt)
#pragma unroll
        for (int i = 0; i < 4; ++i) {
            const int key = kstart + kt * 16 + fq * 4 + i, dist = qpos - key;
            const bool valid = (dist >= 0) && (dist < 128) && (key >= 0);
            const float v = valid ? (s[kt][i] - slope2 * (float)dist) : -__builtin_inff();
            s[kt][i] = v; mx = fmaxf(mx, v);
        }
    mx = fmaxf(mx, __shfl_xor(mx, 16)); mx = fmaxf(mx, __shfl_xor(mx, 32));
    float sum = 0.f;
#pragma unroll
    for (int kt = 1; kt < 10; ++kt)
#pragma unroll
        for (int i = 0; i < 4; ++i) { const float p = __builtin_amdgcn_exp2f(s[kt][i] - mx); s[kt][i] = p; sum += p; }
    sum += __shfl_xor(sum, 16); sum += __shfl_xor(sum, 32);
    sum += __builtin_amdgcn_exp2f(sink2 - mx);
    const float inv = 1.f / sum;
    s[0] = (f32x4){0.f, 0.f, 0.f, 0.f};
    f32x4 o[4];
#pragma unroll
    for (int dt = 0; dt < 4; ++dt) o[dt] = (f32x4){0.f, 0.f, 0.f, 0.f};
#pragma unroll
    for (int c = 0; c < 5; ++c) {
        const u32x4 pw = pg8::pack8(s[2 * c], s[2 * c + 1]);
        const bf16x8 pf = __builtin_bit_cast(bf16x8, pw);
        int kg0 = kstart + 32 * c + fq * 4, kg1 = kg0 + 16; kg0 = kg0 < 0 ? 0 : kg0; kg1 = kg1 < 0 ? 0 : kg1;
#pragma unroll
        for (int dt = 0; dt < 4; ++dt) {
            const bf16_t* vp = VT + (size_t)(kvh * HD + dt * 16 + fr) * S;
            const u32x2 lo = *(const u32x2*)(vp + kg0), hi = *(const u32x2*)(vp + kg1);
            const bf16x8 vf = __builtin_bit_cast(bf16x8, (u32x4){lo.x, lo.y, hi.x, hi.y});
            o[dt] = __builtin_amdgcn_mfma_f32_16x16x32_bf16(vf, pf, o[dt], 0, 0, 0);
        }
    }
    bf16_t* yp = Y + (size_t)(q0 + fr) * MIXW + 2 * CW + h * HD + fq * 4;
#pragma unroll
    for (int dt = 0; dt < 4; ++dt) { const f32x4 v = o[dt] * inv; *(u32x2*)(yp + dt * 16) = (u32x2){cvt_pk_bf16(v[0], v[1]), cvt_pk_bf16(v[2], v[3])}; }
}

constexpr int NPH = 9, NPHASES = DEPTH * NPH;
struct Args { const float* in[20]; float* out; unsigned char* ws; int ph_lo, ph_hi, one, pad; };
typedef const __attribute__((address_space(4))) Args* CArgsP;
#ifndef PH_MASK
#define PH_MASK 0x1ff
#endif
#ifndef PROBE_DUP
#define PROBE_DUP 0
#endif
#define DUPN(k) (1 + ((PROBE_DUP >> (k)) & 1))

#define PHASE_BEGIN() CArgsP p = ap; asm volatile("" : "+s"(p)); int tz = threadIdx.x; asm volatile("" : "+v"(tz)); \
    const int lane = tz & 63, wave = __builtin_amdgcn_readfirstlane(tz >> 6); unsigned char* ws = p->ws; (void)lane; (void)wave; (void)ws; \
    const int G = gridDim.x, bx = blockIdx.x, vcu = (G % 8 == 0) ? (bx % 8) * (G / 8) + bx / 8 : bx, NGW = G * 8, NGT = G * 512; (void)NGW; (void)NGT; (void)vcu
#define GW() (vcu * 8 + wave)
#define GTID() (vcu * 512 + tz)

__global__ void __launch_bounds__(512, 2) fwd(Args a_unused) {
    extern __shared__ __attribute__((aligned(16))) unsigned char lds_raw[];
    LAS unsigned char* lds = (LAS unsigned char*)lds_raw;
    const CArgsP ap = (CArgsP)__builtin_amdgcn_kernarg_segment_ptr();
    for (int u = threadIdx.x; u < (LDS_BYTES - RING_BYTES) / 4; u += 512) ((LAS unsigned*)(lds + RING_BYTES))[u] = 0u;
    __syncthreads();
    if (ap->one) (void)xcd_barrier_post((unsigned*)(ap->ws + WS_CTL) + CW_BAR, (volatile LAS unsigned*)(lds + MISC_OFF) + 8);
#define IN(k) (((PH_MASK >> ((k) % NPH)) & 1) && ap->ph_lo <= (k) && (k) < ap->ph_hi)
#define GRID_BAR(k) do { if (IN(k) && IN((k) + 1)) { XcdBarrier xb_; xb_.bar = (unsigned*)(ws + WS_CTL) + CW_BAR; xb_.x = xb_xcc_id(); xb_.st = (volatile LAS unsigned*)(lds + MISC_OFF) + 8; xcd_barrier(xb_); } } while (0)

    for (int l = 0; l < DEPTH; ++l) {
        const int pb = l * NPH;
        if (IN(pb + 0)) for (int dup_ = 0; dup_ < DUPN(0); ++dup_) {
            PHASE_BEGIN();
            const LayerW W = layer_w(ws, l);
            convert_phase(p->in[1] + (size_t)l * D * NIN, p->in[9] + (size_t)l * MIXW * D, p->in[10] + (size_t)l * D * D, p->in[14] + (size_t)l * D * FF, p->in[16] + (size_t)l * FF * D,
                          p->in[2] + (size_t)l * NIN, W, (float*)(ws + WS_BIASP + (size_t)l * 131072), lds, GW(), NGW, wave, lane, GTID(), NGT);
            if (l == 0) cvt_rows_phase(p->in[0], (bf16_t*)(ws + WS_XB), ws + WS_XQ, GTID(), NGT);
            GRID_BAR(pb + 0);
        }
        if (IN(pb + 1)) for (int dup_ = 0; dup_ < DUPN(1); ++dup_) {
            PHASE_BEGIN();
            const LayerW W = layer_w(ws, l);
            if (INPROJ_BF16_PART) {
              { pg8::Gemm g{ws + WS_XB, W.WinT, D * 2, D * 2, D / 64}; pg8::StaticOrder So; So.init(S, NBF2, G, bx);
                pg8::EpiInProj E{(const float*)(ws + WS_BIASP + (size_t)l * 131072), (bf16_t*)(ws + WS_U), (bf16_t*)(ws + WS_CX), (bf16_t*)(ws + WS_SB), (bf16_t*)(ws + WS_Q), (bf16_t*)(ws + WS_K), (bf16_t*)(ws + WS_VT), (bf16_t*)(ws + WS_SG), 1.f, 0};
                pg8::gemm_phase<pg8::EpiInProj, false>(lds, g, So, E, tz); }
              { pg8::Gemm g{ws + WS_XQ, W.WgQ + (size_t)NBF2 * D, D, D, D / 128}; pg8::BalancedOrder So;
                const int extra = (S / 256) * (NBF2 / 256) - G;
                if (extra > 0 && extra < G) So.init(S, NIN - NBF2, G, bx, ((S / 256) * ((NIN - NBF2) / 256) - 2 * (G - extra)) / G, extra); else So.init(S, NIN - NBF2, G, bx, 1 << 20, 0);
                pg8::EpiInProj E{(const float*)(ws + WS_BIASP + (size_t)l * 131072), (bf16_t*)(ws + WS_U), (bf16_t*)(ws + WS_CX), (bf16_t*)(ws + WS_SB), (bf16_t*)(ws + WS_Q), (bf16_t*)(ws + WS_K), (bf16_t*)(ws + WS_VT), (bf16_t*)(ws + WS_SG), GQ_DESCALE, NBF2 / 256};
                pg8::gemm_phase<pg8::EpiInProj, false, true, pg8::BalancedOrder>(lds, g, So, E, tz); }
            } else {
              pg8::Gemm g{ws + WS_XQ, W.WgQ, D, D, D / 128}; pg8::StaticOrder So; So.init(S, NIN, G, bx);
              pg8::EpiInProj E{(const float*)(ws + WS_BIASP + (size_t)l * 131072), (bf16_t*)(ws + WS_U), (bf16_t*)(ws + WS_CX), (bf16_t*)(ws + WS_SB), (bf16_t*)(ws + WS_Q), (bf16_t*)(ws + WS_K), (bf16_t*)(ws + WS_VT), (bf16_t*)(ws + WS_SG), GQ_DESCALE, 0};
              pg8::gemm_phase<pg8::EpiInProj, false, true>(lds, g, So, E, tz);
            }
            GRID_BAR(pb + 1);
        }
        if (IN(pb + 2)) for (int dup_ = 0; dup_ < DUPN(2); ++dup_) {
            PHASE_BEGIN();
            bf16_t* Yb = (bf16_t*)(ws + WS_Y);
            for (int un = vcu; un < S / 32; un += G)
                convA_unit((const bf16_t*)(ws + WS_U), p->in[3] + (size_t)l * 31 * CW, p->in[4] + (size_t)l * CW, p->in[5] + (size_t)l * CW, p->in[6] + (size_t)l * CW, Yb, un * 32, lds, tz, wave, lane);
            convB_phase((const bf16_t*)(ws + WS_CX), (const bf16_t*)(ws + WS_SB), p->in[7] + (size_t)l * 3 * CW, Yb, GTID(), NGT);
            for (int it = GW(); it < (S / 16) * NQH; it += NGW)
                attn_item((const bf16_t*)(ws + WS_Q), (const bf16_t*)(ws + WS_K), (const bf16_t*)(ws + WS_VT), Yb, p->in[8] + (size_t)l * NQH, it % (S / 16), it / (S / 16), lane);
            GRID_BAR(pb + 2);
        }
        if (IN(pb + 3)) for (int dup_ = 0; dup_ < DUPN(3); ++dup_) {
            PHASE_BEGIN();
            const LayerW W = layer_w(ws, l);
            pg8::Gemm g{ws + WS_Y, W.WbT, MIXW * 2, MIXW * 2, MIXW / 64}; pg8::StaticOrder So; So.init(S, D, G, bx);
            pg8::EpiMerge E{(const bf16_t*)(ws + WS_SG), (bf16_t*)(ws + WS_MG)};
            pg8::gemm_phase<pg8::EpiMerge, true>(lds, g, So, E, tz);
            GRID_BAR(pb + 3);
        }
        if (IN(pb + 4)) for (int dup_ = 0; dup_ < DUPN(4); ++dup_) {
            PHASE_BEGIN();
            const LayerW W = layer_w(ws, l);
            pg8::Gemm g{ws + WS_MG, W.WoT, D * 2, D * 2, D / 64}; pg8::StaticOrder So; So.init(S, D, G, bx);
            pg8::EpiResid E{l == 0 ? p->in[0] : (const float*)(ws + WS_XF), p->in[11] + (size_t)l * D, (float*)(ws + WS_V)};
            pg8::gemm_phase<pg8::EpiResid, false>(lds, g, So, E, tz);
            GRID_BAR(pb + 4);
        }
        if (IN(pb + 5)) for (int dup_ = 0; dup_ < DUPN(5); ++dup_) {
            PHASE_BEGIN();
            ln_phase((const float*)(ws + WS_V), p->in[12] + (size_t)l * D, p->in[13] + (size_t)l * D, (float*)(ws + WS_X1F), (bf16_t*)(ws + WS_X1B), nullptr, GW(), NGW, lane);
            GRID_BAR(pb + 5);
        }
        if (IN(pb + 6)) for (int dup_ = 0; dup_ < DUPN(6); ++dup_) {
            PHASE_BEGIN();
            const LayerW W = layer_w(ws, l);
            pg8::Gemm g{ws + WS_X1B, W.W1T, D * 2, D * 2, D / 64}; pg8::StaticOrder So; So.init(S, FF, G, bx);
            pg8::EpiRelu2 E{p->in[15] + (size_t)l * FF, (bf16_t*)(ws + WS_HID)};
            pg8::gemm_phase<pg8::EpiRelu2, false>(lds, g, So, E, tz);
            GRID_BAR(pb + 6);
        }
        if (IN(pb + 7)) for (int dup_ = 0; dup_ < DUPN(7); ++dup_) {
            PHASE_BEGIN();
            const LayerW W = layer_w(ws, l);
            pg8::Gemm g{ws + WS_HID, W.W2T, FF * 2, FF * 2, FF / 64}; pg8::StaticOrder So; So.init(S, D, G, bx);
            pg8::EpiResid E{(const float*)(ws + WS_X1F), p->in[17] + (size_t)l * D, (float*)(ws + WS_V)};
            pg8::gemm_phase<pg8::EpiResid, false>(lds, g, So, E, tz);
            GRID_BAR(pb + 7);
        }
        if (IN(pb + 8)) for (int dup_ = 0; dup_ < DUPN(8); ++dup_) {
            PHASE_BEGIN();
            ln_phase((const float*)(ws + WS_V), p->in[18] + (size_t)l * D, p->in[19] + (size_t)l * D, l == DEPTH - 1 ? p->out : (float*)(ws + WS_XF), INPROJ_BF16_PART ? (bf16_t*)(ws + WS_XB) : (bf16_t*)nullptr, ws + WS_XQ, GW(), NGW, lane);
            GRID_BAR(pb + 8);
        }
    }
#undef IN
#undef GRID_BAR
}

extern "C" void kernel_launch(void* const* d_in, const int* in_sizes, int n_in, void* d_out, int out_size, void* d_ws, size_t ws_size, hipStream_t stream) {
    static int grid = 0;
    if (grid == 0) {
        if (n_in != 20 || in_sizes[0] != S * D || out_size != S * D || ws_size < WS_END) {
            fprintf(stderr, "kernel_launch: unexpected shapes (n_in %d, in0 %d, out %d, ws %zu, need %zu); nothing launched\n", n_in, n_in > 0 ? in_sizes[0] : -1, out_size, ws_size, (size_t)WS_END); grid = -1; return; }
        int dev = 0, cus = 0, per_cu = 0;
        if (hipGetDevice(&dev) != hipSuccess || hipDeviceGetAttribute(&cus, hipDeviceAttributeMultiprocessorCount, dev) != hipSuccess) { grid = -1; return; }
        if (hipFuncSetAttribute((const void*)fwd, hipFuncAttributeMaxDynamicSharedMemorySize, LDS_BYTES) != hipSuccess) { fprintf(stderr, "kernel_launch: hipFuncSetAttribute failed\n"); grid = -1; return; }
        if (hipOccupancyMaxActiveBlocksPerMultiprocessor(&per_cu, (const void*)fwd, 512, LDS_BYTES) != hipSuccess || per_cu < 1) fprintf(stderr, "kernel_launch: occupancy query reports %d\n", per_cu);
        (void)hipGetLastError();
        grid = cus;
    }
    if (grid < 0) return;
    (void)hipMemsetAsync((char*)d_ws + WS_CTL, 0, CTL_ZERO_BYTES, stream);
    Args a{};
    for (int i = 0; i < 20; ++i) a.in[i] = (const float*)d_in[i];
    a.out = (float*)d_out; a.ws = (unsigned char*)d_ws; a.pad = 0;
#if MK_ONE_LAUNCH
    a.ph_lo = 0; a.ph_hi = NPHASES; a.one = 1;
    hipLaunchKernelGGL(fwd, dim3(grid), dim3(512), LDS_BYTES, stream, a);
#else
    a.one = 0;
    for (int p = 0; p < NPHASES; ++p) { a.ph_lo = p; a.ph_hi = p + 1; hipLaunchKernelGGL(fwd, dim3(grid), dim3(512), LDS_BYTES, stream, a); }
#endif
}
```

```cpp
#include <hip/hip_runtime.h>
#include <cstdio>
#include <cstdint>

#ifndef INPROJ_BF16_PART
#define INPROJ_BF16_PART 1
#endif
#ifndef OUTPROJ_FP8
#define OUTPROJ_FP8 1
#endif
#ifndef MK_ONE_LAUNCH
#define MK_ONE_LAUNCH 1
#endif

#define GAS __attribute__((address_space(1)))
#define LAS __attribute__((address_space(3)))
typedef unsigned short bf16_t;
typedef short bf16x8 __attribute__((ext_vector_type(8)));
typedef float f32x4 __attribute__((ext_vector_type(4)));
typedef float f32x2 __attribute__((ext_vector_type(2)));
typedef unsigned u32x4 __attribute__((ext_vector_type(4)));
typedef unsigned u32x2 __attribute__((ext_vector_type(2)));
typedef int i32x8 __attribute__((ext_vector_type(8)));
typedef int i32x4 __attribute__((ext_vector_type(4)));

constexpr int S = 8192, D = 4096, DEPTH = 4, CW = 768, AW = 1536, KVW = 256, NIN = 18176, FF = 16384, MIXW = 3072, NG = 3 * D;
constexpr int NQH = 24, HD = 64;
constexpr float LN_EPS = 1e-5f;
constexpr float ALPHA = 1.681792830507429f;
constexpr float L2E = 1.4426950408889634f;
constexpr float QSCALE = 0.125f * L2E;
constexpr int NBF = 5888, NBF2 = 2304;
constexpr int NBF_OLD_UNUSED = 0;
constexpr int NBFX = 5888;
constexpr float MQ_SCALE = 64.f, WOQ_SCALE = 2048.f, OQ_DESCALE = 1.f / (64.f * 2048.f);
constexpr float XQ_SCALE = 16.f, WQ_SCALE = 1024.f, GQ_DESCALE = 1.f / (16.f * 1024.f);

constexpr size_t MiB = 1u << 20;
constexpr size_t WS_CTL = 0, CTL_ZERO_BYTES = 1 * MiB;
constexpr size_t WS_BIASP = 1 * MiB;
constexpr size_t WS_XB = 2 * MiB;
constexpr size_t WS_X1B = WS_XB + 64 * MiB;
constexpr size_t WS_XF = WS_X1B + 64 * MiB;
constexpr size_t WS_X1F = WS_XF + 128 * MiB;
constexpr size_t WS_V = WS_X1F + 128 * MiB;
constexpr size_t WS_U = WS_V + 128 * MiB;
constexpr size_t WS_CX = WS_U + 12 * MiB;
constexpr size_t WS_SB = WS_CX + 12 * MiB;
constexpr size_t WS_Q = WS_SB + 12 * MiB;
constexpr size_t WS_K = WS_Q + 24 * MiB;
constexpr size_t WS_VT = WS_K + 4 * MiB;
constexpr size_t WS_SG = WS_VT + 4 * MiB;
constexpr size_t WS_Y = WS_SG + 192 * MiB;
constexpr size_t WS_MG = WS_Y + 48 * MiB;
constexpr size_t WS_HID = WS_MG + 64 * MiB;
constexpr size_t WS_W = WS_HID + 256 * MiB;
constexpr size_t W_IN_B = (size_t)NIN * D * 2, W_B_B = (size_t)D * MIXW * 2, W_O_B = (size_t)D * D * 2, W_1_B = (size_t)FF * D * 2, W_2_B = (size_t)D * FF * 2;
constexpr size_t W_LAYER_B = W_IN_B + W_B_B + W_O_B + W_1_B + W_2_B;
constexpr size_t WS_WG = WS_W + DEPTH * W_LAYER_B;
constexpr size_t W_G_B = (size_t)NIN * D;
constexpr size_t WS_XQ = WS_WG + DEPTH * W_G_B;
constexpr size_t WS_END = WS_XQ + (size_t)S * D;
constexpr int CW_BAR = 4096;

constexpr int RING_BYTES = 131072;
constexpr int MISC_OFF = RING_BYTES + 320;
constexpr int LDS_BYTES = 147456;

#define LDS_WAIT() asm volatile("s_waitcnt lgkmcnt(0)" ::: "memory")
#define VM_WAIT() asm volatile("s_waitcnt vmcnt(0)" ::: "memory")

typedef __bf16 bf16x2_t __attribute__((ext_vector_type(2)));
__device__ __forceinline__ unsigned cvt_pk_bf16(float lo, float hi) { const f32x2 v = {lo, hi}; const bf16x2_t b = __builtin_convertvector(v, bf16x2_t); return __builtin_bit_cast(unsigned, b); }
__device__ __forceinline__ unsigned pk4_fp8(float a, float b, float c, float d) { unsigned w = 0u; w = __builtin_amdgcn_cvt_pk_fp8_f32(a, b, w, false); w = __builtin_amdgcn_cvt_pk_fp8_f32(c, d, w, true); return w; }
__device__ __forceinline__ float bf_lo(unsigned u) { return __builtin_bit_cast(float, u << 16); }
__device__ __forceinline__ float bf_hi(unsigned u) { return __builtin_bit_cast(float, u & 0xffff0000u); }
__device__ __forceinline__ float sigmoidf_fast(float x) { return __builtin_amdgcn_rcpf(1.f + __builtin_amdgcn_exp2f(-L2E * x)); }
__device__ __forceinline__ float wave_sum(float v) {
#pragma unroll
    for (int o = 1; o < 64; o <<= 1) v += __shfl_xor(v, o);
    return v;
}

#define XB_TMO      128
#define XB_XCNT(j)  (256  + 64 * (j))
#define XB_XSUB(j)  (1280 + 64 * (j))
#define XB_XGEN(j)  (2304 + 64 * (j))
#define XB_TOP      3328
#define XB_TOPGEN   3392
#define XCD_BAR_WORDS 3456
#define XB_SPIN_CAP (1u << 20)

__device__ __forceinline__ unsigned xb_ld(unsigned* p)              { return __hip_atomic_load(p, __ATOMIC_RELAXED, __HIP_MEMORY_SCOPE_AGENT); }
__device__ __forceinline__ unsigned xb_add(unsigned* p, unsigned v) { return __hip_atomic_fetch_add(p, v, __ATOMIC_RELAXED, __HIP_MEMORY_SCOPE_AGENT); }
__device__ __forceinline__ unsigned xb_xcc_id() { return (unsigned)__builtin_amdgcn_s_getreg((3 << 11) | 20) & 0xFu; }
#define XB_SPIN(cond, bar) do { unsigned _sp = 0; while (cond) { __builtin_amdgcn_s_sleep(1); \
    if ((++_sp & 255u) == 0u) { if (xb_ld(&(bar)[XB_TMO])) break; if (_sp > XB_SPIN_CAP) { atomicAdd(&(bar)[XB_TMO], 1u); break; } } } } while (0)

struct XcdBarrier { unsigned* bar; unsigned x; volatile LAS unsigned* st; };

__device__ __forceinline__ XcdBarrier xcd_barrier_post(unsigned* bar, volatile LAS unsigned* st) {
    XcdBarrier b; b.bar = bar; b.x = xb_xcc_id(); b.st = st;
    if (threadIdx.x == 0) (void)xb_add(&bar[XB_XCNT(b.x)], 1u);
    return b;
}
__device__ __forceinline__ void xcd_barrier_complete(unsigned* bar, unsigned x, unsigned& nloc, unsigned& nx) {
    const unsigned G = gridDim.x * gridDim.y * gridDim.z;
    unsigned sum, cnt, mine, sp = 0u;
    for (;;) {
        sum = 0u; cnt = 0u; mine = 0u;
#pragma unroll
        for (unsigned j = 0; j < 16; ++j) { const unsigned c = xb_ld(&bar[XB_XCNT(j)]); sum += c; cnt += (c > 0u) ? 1u : 0u; mine = (j == x) ? c : mine; }
        if (sum == G) break;
        __builtin_amdgcn_s_sleep(1);
        if ((++sp & 255u) == 0u) { if (xb_ld(&bar[XB_TMO])) break; if (sp > XB_SPIN_CAP) { atomicAdd(&bar[XB_TMO], 1u); break; } }
    }
    nloc = mine > 0u ? mine : 1u; nx = cnt > 0u ? cnt : 1u;
}
__device__ __forceinline__ void xcd_barrier(const XcdBarrier& b) {
    asm volatile("s_waitcnt vmcnt(0)" ::: "memory");
    __syncthreads();
    if (threadIdx.x == 0) {
        unsigned* bar = b.bar;
        __builtin_amdgcn_s_waitcnt(0);
        unsigned nloc = b.st[0], nx = b.st[1];
        if (nloc == 0u) { xcd_barrier_complete(bar, b.x, nloc, nx); b.st[0] = nloc; b.st[1] = nx; }
        const unsigned old = xb_add(&bar[XB_XSUB(b.x)], 1u);
        const unsigned gen = old / nloc;
        if (old + 1u == (gen + 1u) * nloc) {
            __builtin_amdgcn_fence(__ATOMIC_RELEASE, "agent");
            asm volatile("s_waitcnt vmcnt(0)" ::: "memory");
            const unsigned og = xb_add(&bar[XB_TOP], 1u);
            const unsigned tg = og / nx;
            if (og + 1u == (tg + 1u) * nx) xb_add(&bar[XB_TOPGEN], 1u);
            else XB_SPIN(xb_ld(&bar[XB_TOPGEN]) == tg, bar);
            __builtin_amdgcn_fence(__ATOMIC_ACQUIRE, "agent");
            xb_add(&bar[XB_XGEN(b.x)], 1u);
            asm volatile("s_waitcnt vmcnt(0)" ::: "memory");
        } else {
            XB_SPIN(xb_ld(&bar[XB_XGEN(b.x)]) == gen, bar);
            __builtin_amdgcn_fence(__ATOMIC_ACQUIRE, "agent");
            asm volatile("s_waitcnt vmcnt(0)" ::: "memory");
        }
    }
    __syncthreads();
}

namespace pg8 {
constexpr int BM = 256, BK = 64, HALF = 128, HTB = HALF * BK * 2, NXCD = 8, WGM = 8;
__host__ __device__ __forceinline__ int lds_byte(int r, int c) { const int st = (r >> 4) * 2 + (c >> 5), rr = r & 15, cc = c & 31, ob = rr * 64 + cc * 2; return st * 1024 + (ob ^ (((ob >> 9) & 1) << 5)); }
__host__ __device__ __forceinline__ void stage_rc(int b, int& R, int& C) { const int st = b / 1024, sb = b % 1024, swz = sb ^ (((sb >> 9) & 1) << 5); R = (st >> 1) * 16 + swz / 64; C = (st & 1) * 32 + (swz % 64) / 2; }
__host__ __device__ __forceinline__ int perm32(int rho) { const int n = rho >> 4, i = rho & 15; return 8 * (i >> 2) + 4 * n + (i & 3); }

struct Unit { int pm, pn; };
struct Gemm { const void* A; const void* Bt; int ldaB, ldbB, nt; };

struct StaticOrder {
    int nM, nN, nwg, G, c;
    __device__ void init(int M, int N, int G_, int c_) { nM = M / BM; nN = N / BM; nwg = nM * nN; G = G_; c = c_; }
    __device__ bool next(int i, Unit& u) const {
        const long L = (long)i * G + c; if (L >= nwg) return false;
        int wgid = (int)L; { const int q = nwg / NXCD, r = nwg % NXCD, xcd = wgid % NXCD, off = wgid / NXCD; wgid = (xcd < r ? xcd * (q + 1) : r * (q + 1) + (xcd - r) * q) + off; }
        const int nig = WGM * nN, gid = wgid / nig, fm = gid * WGM, gsz = (nM - fm) < WGM ? (nM - fm) : WGM;
        u.pm = fm + ((wgid % nig) % gsz); u.pn = (wgid % nig) / gsz; return true;
    }
};

struct BalancedOrder {
    int nM, nN, nwg, G, c, R0, C0;
    __device__ void init(int M, int N, int G_, int c_, int R0_, int C0_) { nM = M / BM; nN = N / BM; nwg = nM * nN; G = G_; c = c_; R0 = R0_; C0 = C0_; }
    __device__ bool next(int i, Unit& u) const {
        long L;
        if (i < R0) L = (long)i * G + c; else { if (c < C0) return false; L = (long)R0 * G + (long)(i - R0) * (G - C0) + (c - C0); }
        if (L >= nwg) return false;
        int wgid = (int)L; { const int q = nwg / NXCD, r = nwg % NXCD, xcd = wgid % NXCD, off = wgid / NXCD; wgid = (xcd < r ? xcd * (q + 1) : r * (q + 1) + (xcd - r) * q) + off; }
        const int nig = WGM * nN, gid = wgid / nig, fm = gid * WGM, gsz = (nM - fm) < WGM ? (nM - fm) : WGM;
        u.pm = fm + ((wgid % nig) % gsz); u.pn = (wgid % nig) / gsz; return true;
    }
};

template <class Epi, bool MID, bool FP8 = false, class Sched = StaticOrder>
__device__ __forceinline__ void gemm_phase(LAS unsigned char* lds, const Gemm g, const Sched& S, const Epi& E, const int tid) {
    const int wid = __builtin_amdgcn_readfirstlane(tid >> 6), lane = tid & 63, wr = wid >> 2, wc = wid & 3, fr = lane & 15, fq = lane >> 4;
    const int nt = g.nt;
    unsigned voffA, voffB;
    { int R, C; stage_rc(tid * 16, R, C); const int Rb = (R & ~31) + perm32(R & 31); voffA = (unsigned)(R * g.ldaB + C * 2); voffB = (unsigned)(Rb * g.ldbB + C * 2); }
    const size_t p2A = (size_t)64 * g.ldaB, p2B = (size_t)64 * g.ldbB;
    const size_t kstep = (size_t)(BK * 2);
    const size_t hstepA = (size_t)HALF * g.ldaB, hstepB = (size_t)HALF * g.ldbB;
    const size_t tstepA = 2 * hstepA, tstepB = 2 * hstepB;
    const unsigned ldsw = (unsigned)wid * 1024u;
    constexpr int KOFF = FP8 ? 16 : 1024;
    const int aoff = lds_byte(wr * 64 + fr, FP8 ? fq * 16 : fq * 8), boff = lds_byte(wc * 32 + fr, FP8 ? fq * 16 : fq * 8);
#define PG8_SA(b, h) (((b) * 2 + (h)) * HTB)
#define PG8_SB(b, h) ((4 + (b) * 2 + (h)) * HTB)
#define PG8_STAGE(bufoff, gbase, X) do { _Pragma("unroll") for (int _i = 0; _i < 2; ++_i) \
        __builtin_amdgcn_global_load_lds((const unsigned*)((const char*)(gbase) + (_i ? p2##X : (size_t)0) + voff##X), (LAS unsigned*)(lds + (bufoff) + ldsw + _i * 8192), 16, 0, 0); } while (0)
#define PG8_LD32(p) __builtin_shufflevector(*(const LAS i32x4*)(p), *(const LAS i32x4*)((p) + 16), 0, 1, 2, 3, 4, 5, 6, 7)
#define PG8_LDA(dst, b, h) do { _Pragma("unroll") for (int m = 0; m < 4; ++m) { if constexpr (FP8) dst##8[m] = PG8_LD32(lds + PG8_SA(b, h) + aoff + m * 2048); else { _Pragma("unroll") for (int k = 0; k < 2; ++k) dst[m][k] = *(const LAS bf16x8*)(lds + PG8_SA(b, h) + aoff + m * 2048 + k * KOFF); } } } while (0)
#define PG8_LDB(dst, b, h) do { _Pragma("unroll") for (int n = 0; n < 2; ++n) { if constexpr (FP8) dst##8[n] = PG8_LD32(lds + PG8_SB(b, h) + boff + n * 2048); else { _Pragma("unroll") for (int k = 0; k < 2; ++k) dst[n][k] = *(const LAS bf16x8*)(lds + PG8_SB(b, h) + boff + n * 2048 + k * KOFF); } } } while (0)
#define PG8_CAT8(x) __builtin_shufflevector(__builtin_bit_cast(i32x4, (x)[0]), __builtin_bit_cast(i32x4, (x)[1]), 0, 1, 2, 3, 4, 5, 6, 7)
#define PG8_MMA(ai, bj, At, Bt) do { __builtin_amdgcn_s_setprio(1); _Pragma("unroll") for (int m = 0; m < 4; ++m) _Pragma("unroll") for (int n = 0; n < 2; ++n) { \
        if constexpr (FP8) asm volatile("v_mfma_scale_f32_16x16x128_f8f6f4 %0, %1, %2, %0, %3, %3 op_sel_hi:[0,0,0]" : "+v"(acc[ai][bj][m][n]) : "v"(Bt##8[n]), "v"(At##8[m]), "v"(sc127)); \
        else { _Pragma("unroll") for (int k = 0; k < 2; ++k) acc[ai][bj][m][n] = __builtin_amdgcn_mfma_f32_16x16x32_bf16(Bt[n][k], At[m][k], acc[ai][bj][m][n], 0, 0, 0); } } \
        __builtin_amdgcn_s_setprio(0); } while (0)
#define PG8_WAIT_V(n) asm volatile("s_waitcnt vmcnt(" #n ")" ::: "memory")
#define PG8_WAIT_L(n) asm volatile("s_waitcnt lgkmcnt(" #n ")" ::: "memory")
#define PG8_BAR __builtin_amdgcn_s_barrier()
#define PG8_SCHED __builtin_amdgcn_sched_barrier(0)
    Unit cur, nxt; int ui = 0;
    if (!S.next(0, cur)) return;
    f32x4 acc[2][2][4][2];
#pragma unroll
    for (int a = 0; a < 2; ++a)
#pragma unroll
        for (int b = 0; b < 2; ++b)
#pragma unroll
            for (int m = 0; m < 4; ++m)
#pragma unroll
                for (int n = 0; n < 2; ++n) acc[a][b][m][n] = (f32x4){0.f, 0.f, 0.f, 0.f};
    int sc127 = 127; asm volatile("" : "+v"(sc127));
    bf16x8 At[4][2], B0[2][2], B1[2][2]; i32x8 At8[4], B08[2], B18[2]; (void)At; (void)B0; (void)B1; (void)At8; (void)B08; (void)B18;
    const char* cA = (const char*)g.A + (size_t)cur.pm * tstepA; const char* cB = (const char*)g.Bt + (size_t)cur.pn * tstepB;
    PG8_STAGE(PG8_SB(0, 0), cB, B); PG8_STAGE(PG8_SB(0, 1), cB + hstepB, B); PG8_STAGE(PG8_SA(0, 0), cA, A); PG8_STAGE(PG8_SA(0, 1), cA + hstepA, A);
    if (wr == 1) PG8_BAR;
    PG8_WAIT_V(2); PG8_BAR;
    PG8_STAGE(PG8_SB(1, 0), cB + kstep, B); PG8_STAGE(PG8_SA(1, 0), cA + kstep, A); PG8_STAGE(PG8_SB(1, 1), cB + hstepB + kstep, B);
    PG8_WAIT_V(6); PG8_BAR;
    for (;;) {
        const bool has_next = S.next(ui + 1, nxt);
        const char* nA = has_next ? (const char*)g.A + (size_t)nxt.pm * tstepA : cA; const char* nB = has_next ? (const char*)g.Bt + (size_t)nxt.pn * tstepB : cB;
        for (int t = 0; t < nt; t += 2) {
            const bool last = (t == nt - 2);
            const char* a1 = cA + (size_t)(t + 1) * kstep;
            const char* a2 = last ? nA : cA + (size_t)(t + 2) * kstep; const char* b2 = last ? nB : cB + (size_t)(t + 2) * kstep;
            const char* a3 = a2 + kstep; const char* b3 = b2 + kstep;
            PG8_LDB(B0, 0, 0); PG8_LDB(B1, 0, 1); PG8_SCHED; PG8_LDA(At, 0, 0); PG8_STAGE(PG8_SA(1, 1), a1 + hstepA, A);
            PG8_WAIT_V(8); PG8_WAIT_L(0); PG8_BAR; PG8_MMA(0, 0, At, B0); PG8_MMA(0, 1, At, B1); PG8_BAR; PG8_SCHED;
            PG8_LDA(At, 0, 1); PG8_STAGE(PG8_SB(0, 0), b2, B); PG8_STAGE(PG8_SB(0, 1), b2 + hstepB, B); PG8_STAGE(PG8_SA(0, 0), a2, A);
            PG8_WAIT_V(8); PG8_WAIT_L(0); PG8_BAR; PG8_MMA(1, 0, At, B0); PG8_MMA(1, 1, At, B1); PG8_BAR; PG8_SCHED;
            PG8_LDB(B0, 1, 0); PG8_LDB(B1, 1, 1); PG8_SCHED; PG8_LDA(At, 1, 0); PG8_STAGE(PG8_SA(0, 1), a2 + hstepA, A);
            PG8_WAIT_V(8); PG8_WAIT_L(0); PG8_BAR; PG8_MMA(0, 0, At, B0); PG8_MMA(0, 1, At, B1); PG8_BAR; PG8_SCHED;
            PG8_LDA(At, 1, 1); PG8_STAGE(PG8_SB(1, 0), b3, B); PG8_STAGE(PG8_SB(1, 1), b3 + hstepB, B); PG8_STAGE(PG8_SA(1, 0), a3, A);
            PG8_WAIT_V(8); PG8_WAIT_L(0); PG8_BAR; PG8_MMA(1, 0, At, B0); PG8_MMA(1, 1, At, B1); PG8_BAR; PG8_SCHED;
            if constexpr (MID) { if (t + 2 == Epi::MID1 || t + 2 == Epi::MID2) { E.mid(acc, cur, (t + 2 == Epi::MID1) ? 0 : 1, wr, wc, fr, fq); PG8_SCHED; } }
        }
        if (wr == 0) PG8_BAR;
        if constexpr (FP8) asm volatile("s_nop 15\n\ts_nop 15" ::: "memory");
        E(acc, cur, wr, wc, fr, fq);
        if (!has_next) break;
#pragma unroll
        for (int a = 0; a < 2; ++a)
#pragma unroll
            for (int b = 0; b < 2; ++b)
#pragma unroll
                for (int m = 0; m < 4; ++m)
#pragma unroll
                    for (int n = 0; n < 2; ++n) acc[a][b][m][n] = (f32x4){0.f, 0.f, 0.f, 0.f};
        cur = nxt; cA = nA; cB = nB; ++ui;
        if (wr == 1) PG8_BAR;
    }
    PG8_WAIT_V(0);
    PG8_BAR;
#undef PG8_SA
#undef PG8_SB
#undef PG8_STAGE
#undef PG8_LDA
#undef PG8_LD32
#undef PG8_LDB
#undef PG8_MMA
#undef PG8_CAT8
#undef PG8_WAIT_V
#undef PG8_WAIT_L
#undef PG8_BAR
#undef PG8_SCHED
}

__device__ __forceinline__ u32x4 pack8(f32x4 a, f32x4 b) { u32x4 w; w.x = cvt_pk_bf16(a[0], a[1]); w.y = cvt_pk_bf16(a[2], a[3]); w.z = cvt_pk_bf16(b[0], b[1]); w.w = cvt_pk_bf16(b[2], b[3]); return w; }
__device__ __forceinline__ f32x4 sig4(f32x4 v) { f32x4 r; r[0] = sigmoidf_fast(v[0]); r[1] = sigmoidf_fast(v[1]); r[2] = sigmoidf_fast(v[2]); r[3] = sigmoidf_fast(v[3]); return r; }
__device__ __forceinline__ f32x4 clamp4(f32x4 v, float lo, float hi) { f32x4 r; for (int i = 0; i < 4; ++i) r[i] = fminf(fmaxf(v[i], lo), hi); return r; }

struct EpiInProj {
    const float* bias;
    bf16_t *U, *CX, *SBb, *Q, *Kb, *VT, *SG; float ds; int t0;
    __device__ __forceinline__ void operator()(const f32x4 (&acc)[2][2][4][2], const Unit& u, int wr, int wc, int fr, int fq) const {
        const int t = u.pn + t0, row0 = u.pm * BM + wr * 64 + fr, cw = wc * 32 + 8 * fq;
        f32x4 bv[2][2];
#define LOAD_BV() _Pragma("unroll") for (int bj = 0; bj < 2; ++bj) _Pragma("unroll") for (int n = 0; n < 2; ++n) bv[bj][n] = *(const f32x4*)(bias + t * BM + bj * HALF + cw + 4 * n)
        if (t < 6 || (t >= 9 && t < 15)) {
            LOAD_BV();
            const bool glu = t >= 9; bf16_t* O = (glu ? U : CX) + (glu ? t - 9 : t) * HALF + cw;
#pragma unroll
            for (int ai = 0; ai < 2; ++ai)
#pragma unroll
                for (int m = 0; m < 4; ++m) {
                    const int row = row0 + ai * HALF + m * 16;
                    f32x4 a0 = acc[ai][0][m][0] * ds + bv[0][0], a1 = acc[ai][0][m][1] * ds + bv[0][1], g0 = acc[ai][1][m][0] * ds + bv[1][0], g1 = acc[ai][1][m][1] * ds + bv[1][1];
                    if (glu) { g0 = sig4(g0); g1 = sig4(g1); }
                    *(u32x4*)(O + (size_t)row * CW) = pack8(a0 * g0, a1 * g1);
                }
        } else if (t == 22) {
            LOAD_BV();
#pragma unroll
            for (int ai = 0; ai < 2; ++ai)
#pragma unroll
                for (int m = 0; m < 4; ++m) {
                    const int row = row0 + ai * HALF + m * 16;
#pragma unroll
                    for (int bj = 0; bj < 2; ++bj) {
                        const u32x4 w = pack8(acc[ai][bj][m][0] * ds + bv[bj][0], acc[ai][bj][m][1] * ds + bv[bj][1]);
                        bf16_t* o = VT + (size_t)(bj * HALF + cw) * S + (row & ~31) + (fr >> 2) * 8 + (m & 1) * 4 + (fr & 3);
                        o[0 * (size_t)S] = (bf16_t)(w.x & 0xffffu); o[1 * (size_t)S] = (bf16_t)(w.x >> 16); o[2 * (size_t)S] = (bf16_t)(w.y & 0xffffu); o[3 * (size_t)S] = (bf16_t)(w.y >> 16);
                        o[4 * (size_t)S] = (bf16_t)(w.z & 0xffffu); o[5 * (size_t)S] = (bf16_t)(w.z >> 16); o[6 * (size_t)S] = (bf16_t)(w.w & 0xffffu); o[7 * (size_t)S] = (bf16_t)(w.w >> 16);
                    }
                }
        } else {
            bf16_t* O; int ld; float sc = 1.f; bool sg = false;
            if (t < 9) { O = SBb + (t - 6) * BM; ld = CW; }
            else if (t < 21) { O = Q + (t - 15) * BM; ld = AW; sc = QSCALE; }
            else if (t == 21) { O = Kb; ld = KVW; }
            else { O = SG + (t - 23) * BM; ld = NG; sg = true; }
            O += cw;
            LOAD_BV();
#pragma unroll
            for (int ai = 0; ai < 2; ++ai)
#pragma unroll
                for (int m = 0; m < 4; ++m) {
                    const int row = row0 + ai * HALF + m * 16;
#pragma unroll
                    for (int bj = 0; bj < 2; ++bj) {
                        f32x4 v0 = acc[ai][bj][m][0] * ds + bv[bj][0], v1 = acc[ai][bj][m][1] * ds + bv[bj][1];
                        if (sg) { v0 = sig4(clamp4(v0, -60.f, 60.f)); v1 = sig4(clamp4(v1, -60.f, 60.f)); } else { v0 = v0 * sc; v1 = v1 * sc; }
                        *(u32x4*)(O + (size_t)row * ld + bj * HALF) = pack8(v0, v1);
                    }
                }
        }
    }
};

struct EpiGates {
    const float* bias; bf16_t* SG;
    __device__ __forceinline__ void operator()(const f32x4 (&acc)[2][2][4][2], const Unit& u, int wr, int wc, int fr, int fq) const {
        const int row0 = u.pm * BM + wr * 64 + fr, col0 = u.pn * BM + wc * 32 + 8 * fq;
        f32x4 bv[2][2];
#pragma unroll
        for (int bj = 0; bj < 2; ++bj)
#pragma unroll
            for (int n = 0; n < 2; ++n) bv[bj][n] = *(const f32x4*)(bias + col0 + bj * HALF + 4 * n);
#pragma unroll
        for (int ai = 0; ai < 2; ++ai)
#pragma unroll
            for (int m = 0; m < 4; ++m)
#pragma unroll
                for (int bj = 0; bj < 2; ++bj) {
                    const f32x4 v0 = sig4(clamp4(acc[ai][bj][m][0] * GQ_DESCALE + bv[bj][0], -60.f, 60.f)), v1 = sig4(clamp4(acc[ai][bj][m][1] * GQ_DESCALE + bv[bj][1], -60.f, 60.f));
                    *(u32x4*)(SG + (size_t)(row0 + ai * HALF + m * 16) * NG + col0 + bj * HALF) = pack8(v0, v1);
                }
    }
};

__device__ __forceinline__ f32x4 up_lo(u32x2 p) { return (f32x4){bf_lo(p.x), bf_hi(p.x), bf_lo(p.y), bf_hi(p.y)}; }
__device__ __forceinline__ f32x4 rcp4(f32x4 v) { f32x4 r; for (int i = 0; i < 4; ++i) r[i] = __builtin_amdgcn_rcpf(v[i]); return r; }

struct EpiMerge {
    static constexpr int MID1 = CW / BK, MID2 = 2 * CW / BK;
    const bf16_t* SG; bf16_t* MG;
    __device__ __forceinline__ void mid(f32x4 (&acc)[2][2][4][2], const Unit& u, int which, int wr, int wc, int fr, int fq) const {
        const unsigned loff = (unsigned)(fr * NG + 8 * fq) * 2u;
        const char* nb = (const char*)SG + ((size_t)(u.pm * BM + wr * 64) * NG + (size_t)which * D + u.pn * BM + wc * 32) * 2;
#pragma unroll
        for (int ai = 0; ai < 2; ++ai)
#pragma unroll
            for (int bj = 0; bj < 2; ++bj) {
                u32x4 nv[4], dv[4];
#pragma unroll
                for (int m = 0; m < 4; ++m) { const char* p = nb + ((size_t)(ai * HALF + m * 16) * NG + bj * HALF) * 2; nv[m] = *(const u32x4*)(p + loff); dv[m] = *(const u32x4*)(p + (size_t)D * 2 + loff); }
#pragma unroll
                for (int m = 0; m < 4; ++m) {
                    const f32x4 r0 = up_lo((u32x2){nv[m].x, nv[m].y}) * rcp4(up_lo((u32x2){dv[m].x, dv[m].y}));
                    const f32x4 r1 = up_lo((u32x2){nv[m].z, nv[m].w}) * rcp4(up_lo((u32x2){dv[m].z, dv[m].w}));
                    acc[ai][bj][m][0] = acc[ai][bj][m][0] * r0; acc[ai][bj][m][1] = acc[ai][bj][m][1] * r1;
                }
                __builtin_amdgcn_sched_barrier(0);
            }
    }
    __device__ __forceinline__ void operator()(const f32x4 (&acc)[2][2][4][2], const Unit& u, int wr, int wc, int fr, int fq) const {
        const unsigned loff = (unsigned)(fr * NG + 8 * fq) * 2u, loffo = (unsigned)(fr * D + 8 * fq) * 2u;
        const char* gb = (const char*)SG + ((size_t)(u.pm * BM + wr * 64) * NG + (size_t)2 * D + u.pn * BM + wc * 32) * 2;
        char* ob = (char*)MG + ((size_t)(u.pm * BM + wr * 64) * D + u.pn * BM + wc * 32) * 2;
#pragma unroll
        for (int ai = 0; ai < 2; ++ai)
#pragma unroll
            for (int bj = 0; bj < 2; ++bj) {
                u32x4 gv[4];
#pragma unroll
                for (int m = 0; m < 4; ++m) gv[m] = *(const u32x4*)(gb + ((size_t)(ai * HALF + m * 16) * NG + bj * HALF) * 2 + loff);
#pragma unroll
                for (int m = 0; m < 4; ++m) {
                    const f32x4 v0 = acc[ai][bj][m][0] * up_lo((u32x2){gv[m].x, gv[m].y}), v1 = acc[ai][bj][m][1] * up_lo((u32x2){gv[m].z, gv[m].w});
                    if (OUTPROJ_FP8) *(u32x2*)((char*)MG + ((size_t)(u.pm * BM + wr * 64 + ai * HALF + m * 16) * D + u.pn * BM + wc * 32 + bj * HALF) + (unsigned)(fr * D + 8 * fq)) = (u32x2){pk4_fp8(v0[0] * MQ_SCALE, v0[1] * MQ_SCALE, v0[2] * MQ_SCALE, v0[3] * MQ_SCALE), pk4_fp8(v1[0] * MQ_SCALE, v1[1] * MQ_SCALE, v1[2] * MQ_SCALE, v1[3] * MQ_SCALE)};
                    else *(u32x4*)(ob + ((size_t)(ai * HALF + m * 16) * D + bj * HALF) * 2 + loffo) = pack8(v0, v1);
                }
                __builtin_amdgcn_sched_barrier(0);
            }
    }
};

struct EpiResid {
    const float* R; const float* bias; float* O; float ds;
    __device__ __forceinline__ void operator()(const f32x4 (&acc)[2][2][4][2], const Unit& u, int wr, int wc, int fr, int fq) const {
        const int row0 = u.pm * BM + wr * 64 + fr, col0 = u.pn * BM + wc * 32 + 8 * fq;
        f32x4 bv[2][2];
#pragma unroll
        for (int bj = 0; bj < 2; ++bj)
#pragma unroll
            for (int n = 0; n < 2; ++n) bv[bj][n] = *(const f32x4*)(bias + col0 + bj * HALF + 4 * n);
#pragma unroll
        for (int ai = 0; ai < 2; ++ai) {
            f32x4 rv[4][2][2];
#pragma unroll
            for (int m = 0; m < 4; ++m)
#pragma unroll
                for (int bj = 0; bj < 2; ++bj)
#pragma unroll
                    for (int n = 0; n < 2; ++n) rv[m][bj][n] = *(const f32x4*)(R + (size_t)(row0 + ai * HALF + m * 16) * D + col0 + bj * HALF + 4 * n);
#pragma unroll
            for (int m = 0; m < 4; ++m)
#pragma unroll
                for (int bj = 0; bj < 2; ++bj)
#pragma unroll
                    for (int n = 0; n < 2; ++n) *(f32x4*)(O + (size_t)(row0 + ai * HALF + m * 16) * D + col0 + bj * HALF + 4 * n) = rv[m][bj][n] * ALPHA + acc[ai][bj][m][n] * ds + bv[bj][n];
            __builtin_amdgcn_sched_barrier(0);
        }
    }
};

struct EpiRelu2 {
    const float* bias; bf16_t* O;
    __device__ __forceinline__ void operator()(const f32x4 (&acc)[2][2][4][2], const Unit& u, int wr, int wc, int fr, int fq) const {
        const int row0 = u.pm * BM + wr * 64 + fr, col0 = u.pn * BM + wc * 32 + 8 * fq;
        f32x4 bv[2][2];
#pragma unroll
        for (int bj = 0; bj < 2; ++bj)
#pragma unroll
            for (int n = 0; n < 2; ++n) bv[bj][n] = *(const f32x4*)(bias + col0 + bj * HALF + 4 * n);
#pragma unroll
        for (int ai = 0; ai < 2; ++ai)
#pragma unroll
            for (int m = 0; m < 4; ++m)
#pragma unroll
                for (int bj = 0; bj < 2; ++bj) {
                    f32x4 v0 = acc[ai][bj][m][0] + bv[bj][0], v1 = acc[ai][bj][m][1] + bv[bj][1];
#pragma unroll
                    for (int i = 0; i < 4; ++i) { v0[i] = fmaxf(v0[i], 0.f); v0[i] *= v0[i]; v1[i] = fmaxf(v1[i], 0.f); v1[i] *= v1[i]; }
                    *(u32x4*)(O + (size_t)(row0 + ai * HALF + m * 16) * FF + col0 + bj * HALF) = pack8(v0, v1);
                }
    }
};
}

__host__ __device__ __forceinline__ int inproj_dst_row(int o) {
    if (o < 768) return 256 * (9 + o / 128) + (o % 128);
    if (o < 1536) { const int c = o - 768; return 256 * (9 + c / 128) + 128 + (c % 128); }
    if (o < 2304) return 6 * 256 + (o - 1536);
    if (o < 3072) { const int c = o - 2304; return 256 * (c / 128) + (c % 128); }
    if (o < 3840) { const int c = o - 3072; return 256 * (c / 128) + 128 + (c % 128); }
    return o;
}

__device__ __forceinline__ void transpose_item(const float* __restrict__ W, int N, bf16_t* WT, int K, int k0, int n0, int dst_row, LAS float* scr, int lane) {
    const int kr = lane >> 3, nc = lane & 7;
    f32x4 v[8];
#pragma unroll
    for (int i = 0; i < 8; ++i) v[i] = *(const f32x4*)(W + (size_t)(k0 + 8 * i + kr) * N + n0 + 4 * nc);
#pragma unroll
    for (int i = 0; i < 8; ++i) { LAS float* s = scr + (8 * i + kr) * 33 + 4 * nc; s[0] = v[i][0]; s[1] = v[i][1]; s[2] = v[i][2]; s[3] = v[i][3]; }
    LDS_WAIT();
    const int c = lane & 7;
#pragma unroll
    for (int j = 0; j < 4; ++j) { const int n = (lane >> 3) + 8 * j; const LAS float* s = scr + (8 * c) * 33 + n;
        u32x4 o; o.x = cvt_pk_bf16(s[0 * 33], s[1 * 33]); o.y = cvt_pk_bf16(s[2 * 33], s[3 * 33]); o.z = cvt_pk_bf16(s[4 * 33], s[5 * 33]); o.w = cvt_pk_bf16(s[6 * 33], s[7 * 33]);
        *(u32x4*)(WT + (size_t)(dst_row + n) * K + k0 + 8 * c) = o; }
    LDS_WAIT();
}

__device__ __forceinline__ void transpose_item_fp8(const float* __restrict__ W, int N, unsigned char* WT8, int K, int k0, int n0, int dst_row, LAS float* scr, int lane, const float wsc = WQ_SCALE) {
    const int kr = lane >> 3, nc = lane & 7;
    f32x4 v[8];
#pragma unroll
    for (int i = 0; i < 8; ++i) v[i] = *(const f32x4*)(W + (size_t)(k0 + 8 * i + kr) * N + n0 + 4 * nc);
#pragma unroll
    for (int i = 0; i < 8; ++i) { LAS float* s = scr + (8 * i + kr) * 33 + 4 * nc; s[0] = v[i][0] * wsc; s[1] = v[i][1] * wsc; s[2] = v[i][2] * wsc; s[3] = v[i][3] * wsc; }
    LDS_WAIT();
    const int c = lane & 3;
#pragma unroll
    for (int j = 0; j < 2; ++j) { const int n = (lane >> 2) + 16 * j; const LAS float* s = scr + (16 * c) * 33 + n;
        u32x4 o; o.x = pk4_fp8(s[0 * 33], s[1 * 33], s[2 * 33], s[3 * 33]); o.y = pk4_fp8(s[4 * 33], s[5 * 33], s[6 * 33], s[7 * 33]);
        o.z = pk4_fp8(s[8 * 33], s[9 * 33], s[10 * 33], s[11 * 33]); o.w = pk4_fp8(s[12 * 33], s[13 * 33], s[14 * 33], s[15 * 33]);
        *(u32x4*)(WT8 + (size_t)(dst_row + n) * K + k0 + 16 * c) = o; }
    LDS_WAIT();
}

struct LayerW { bf16_t *WinT, *WbT, *WoT, *W1T, *W2T; unsigned char* WgQ; };
__device__ __forceinline__ LayerW layer_w(unsigned char* ws, int l) {
    unsigned char* b = ws + WS_W + (size_t)l * W_LAYER_B; LayerW w;
    w.WgQ = ws + WS_WG + (size_t)l * W_G_B;
    w.WinT = (bf16_t*)b; w.WbT = (bf16_t*)(b + W_IN_B); w.WoT = (bf16_t*)(b + W_IN_B + W_B_B); w.W1T = (bf16_t*)(b + W_IN_B + W_B_B + W_O_B); w.W2T = (bf16_t*)(b + W_IN_B + W_B_B + W_O_B + W_1_B);
    return w;
}

__device__ __forceinline__ void convert_phase(const float* w_in, const float* w_br, const float* w_out, const float* w_1, const float* w_2, const float* b_in, const LayerW& W, float* biasP,
                                              LAS unsigned char* lds, int gw, int NGW, int wave, int lane, int gtid, int NGT) {
    LAS float* scr = (LAS float*)(lds + wave * 16384);
    constexpr int I_IN = (D / 64) * (NIN / 32), I_B = (MIXW / 64) * (D / 32), I_O = (D / 64) * (D / 32), I_1 = (D / 64) * (FF / 32), I_2 = (FF / 64) * (D / 32);
    constexpr int NITEMS = I_IN + I_B + I_O + I_1 + I_2;
    for (int it = gw; it < NITEMS; it += NGW) {
        int r = it;
        if (r < I_IN) { const int nb = r % (NIN / 32), kb = r / (NIN / 32);
            if (INPROJ_BF16_PART && inproj_dst_row(32 * nb) < NBF2) transpose_item(w_in, NIN, W.WinT, D, 64 * kb, 32 * nb, inproj_dst_row(32 * nb), scr, lane);
            else transpose_item_fp8(w_in, NIN, W.WgQ, D, 64 * kb, 32 * nb, inproj_dst_row(32 * nb), scr, lane);
            continue; } r -= I_IN;
        if (r < I_B) { const int nb = r % (D / 32), kb = r / (D / 32); transpose_item(w_br, D, W.WbT, MIXW, 64 * kb, 32 * nb, 32 * nb, scr, lane); continue; } r -= I_B;
        if (r < I_O) { const int nb = r % (D / 32), kb = r / (D / 32);
            if (OUTPROJ_FP8) transpose_item_fp8(w_out, D, (unsigned char*)W.WoT, D, 64 * kb, 32 * nb, 32 * nb, scr, lane, WOQ_SCALE); else transpose_item(w_out, D, W.WoT, D, 64 * kb, 32 * nb, 32 * nb, scr, lane);
            continue; } r -= I_O;
        if (r < I_1) { const int nb = r % (FF / 32), kb = r / (FF / 32); transpose_item(w_1, FF, W.W1T, D, 64 * kb, 32 * nb, 32 * nb, scr, lane); continue; } r -= I_1;
        { const int nb = r % (D / 32), kb = r / (D / 32); transpose_item(w_2, D, W.W2T, FF, 64 * kb, 32 * nb, 32 * nb, scr, lane); }
    }
    for (int o = gtid; o < NIN; o += NGT) biasP[inproj_dst_row(o)] = b_in[o];
}

__device__ __forceinline__ void cvt_rows_phase(const float* X, bf16_t* XB, unsigned char* XQ, int gtid, int NGT) {
    for (size_t i = (size_t)gtid; i < (size_t)S * D / 8; i += (size_t)NGT) {
        const f32x4 a = *(const f32x4*)(X + i * 8), b = *(const f32x4*)(X + i * 8 + 4);
        if (INPROJ_BF16_PART) *(u32x4*)(XB + i * 8) = pg8::pack8(a, b);
        *(u32x2*)(XQ + i * 8) = (u32x2){pk4_fp8(a[0] * XQ_SCALE, a[1] * XQ_SCALE, a[2] * XQ_SCALE, a[3] * XQ_SCALE), pk4_fp8(b[0] * XQ_SCALE, b[1] * XQ_SCALE, b[2] * XQ_SCALE, b[3] * XQ_SCALE)};
    }
}

__device__ __forceinline__ void ln_phase(const float* V, const float* g, const float* b, float* OF, bf16_t* OB, unsigned char* OQ, int gw, int NGW, int lane) {
    for (int row = gw; row < S; row += NGW) {
        const f32x4* vr = (const f32x4*)(V + (size_t)row * D) + lane;
        f32x4 v[16]; float s = 0.f;
#pragma unroll
        for (int j = 0; j < 16; ++j) { v[j] = vr[64 * j]; s += (v[j][0] + v[j][1]) + (v[j][2] + v[j][3]); }
        const float mean = wave_sum(s) * (1.f / D); float s2 = 0.f;
#pragma unroll
        for (int j = 0; j < 16; ++j) { v[j] = v[j] - mean; s2 += (v[j][0] * v[j][0] + v[j][1] * v[j][1]) + (v[j][2] * v[j][2] + v[j][3] * v[j][3]); }
        const float rstd = 1.f / sqrtf(wave_sum(s2) * (1.f / D) + LN_EPS);
        f32x4* of = (f32x4*)(OF + (size_t)row * D) + lane; u32x2* ob = (u32x2*)(OB + (size_t)row * D) + lane;
#pragma unroll
        for (int j = 0; j < 16; ++j) {
            const f32x4 gg = ((const f32x4*)g)[64 * j + lane], bb = ((const f32x4*)b)[64 * j + lane];
            const f32x4 y = v[j] * rstd * gg + bb;
            of[64 * j] = y; if (OB) ob[64 * j] = (u32x2){cvt_pk_bf16(y[0], y[1]), cvt_pk_bf16(y[2], y[3])};
            if (OQ) ((unsigned*)(OQ + (size_t)row * D))[64 * j + lane] = pk4_fp8(y[0] * XQ_SCALE, y[1] * XQ_SCALE, y[2] * XQ_SCALE, y[3] * XQ_SCALE);
        }
    }
}

__device__ __forceinline__ void convB_phase(const bf16_t* CX, const bf16_t* SBb, const float* w3, bf16_t* Y, int gtid, int NGT) {
    for (int idx = gtid; idx < S * (CW / 8); idx += NGT) {
        const int t = idx / (CW / 8), c = (idx % (CW / 8)) * 8;
        const u32x4 z = (u32x4){0u, 0u, 0u, 0u};
        const u32x4 x2 = *(const u32x4*)(CX + (size_t)t * CW + c);
        const u32x4 x1 = t >= 1 ? *(const u32x4*)(CX + (size_t)(t - 1) * CW + c) : z;
        const u32x4 x0 = t >= 2 ? *(const u32x4*)(CX + (size_t)(t - 2) * CW + c) : z;
        const u32x4 sb = *(const u32x4*)(SBb + (size_t)t * CW + c);
        float o[8];
#pragma unroll
        for (int e = 0; e < 4; ++e) {
            const f32x2 w0 = *(const f32x2*)(w3 + 0 * CW + c + 2 * e), w1 = *(const f32x2*)(w3 + 1 * CW + c + 2 * e), w2 = *(const f32x2*)(w3 + 2 * CW + c + 2 * e);
            o[2 * e] = bf_lo(sb[e]) * (w0[0] * bf_lo(x0[e]) + w1[0] * bf_lo(x1[e]) + w2[0] * bf_lo(x2[e]));
            o[2 * e + 1] = bf_hi(sb[e]) * (w0[1] * bf_hi(x0[e]) + w1[1] * bf_hi(x1[e]) + w2[1] * bf_hi(x2[e]));
        }
        u32x4 w; w.x = cvt_pk_bf16(o[0], o[1]); w.y = cvt_pk_bf16(o[2], o[3]); w.z = cvt_pk_bf16(o[4], o[5]); w.w = cvt_pk_bf16(o[6], o[7]);
        *(u32x4*)(Y + (size_t)t * MIXW + CW + c) = w;
    }
}

__device__ __forceinline__ void convA_unit(const bf16_t* U, const float* w, const float* cb, const float* g, const float* b, bf16_t* Y, int r0, LAS unsigned char* lds, int tid, int wave, int lane) {
    for (int c = tid; c < 62 * 96; c += 512) { const int rr = c / 96, cc = c % 96, gr = r0 - 30 + rr;
        const u32x4 v = gr >= 0 ? *(const u32x4*)(U + (size_t)gr * CW + cc * 8) : (u32x4){0u, 0u, 0u, 0u};
        *(LAS u32x4*)(lds + rr * 1536 + cc * 16) = v; }
    __syncthreads();
    f32x2 acc[4][6], w0[6], w1[6], w2[6], w3[6];
#pragma unroll
    for (int j = 0; j < 6; ++j) { w1[j] = (f32x2){0.f, 0.f}; w2[j] = w1[j]; w3[j] = w1[j]; w0[j] = w1[j];
#pragma unroll
        for (int r = 0; r < 4; ++r) acc[r][j] = (f32x2){0.f, 0.f}; }
    const LAS unsigned char* lrow = lds + (4 * wave) * 1536 + lane * 4;
#pragma unroll 2
    for (int i = 0; i < 34; ++i) {
#pragma unroll
        for (int j = 0; j < 6; ++j) { w3[j] = w2[j]; w2[j] = w1[j]; w1[j] = w0[j]; w0[j] = (i <= 30) ? *(const f32x2*)(w + (size_t)(i <= 30 ? i : 30) * CW + 2 * lane + 128 * j) : (f32x2){0.f, 0.f}; }
#pragma unroll
        for (int j = 0; j < 6; ++j) {
            const unsigned p = *(const LAS unsigned*)(lrow + i * 1536 + j * 256);
            const f32x2 uu = (f32x2){bf_lo(p), bf_hi(p)};
            acc[0][j] += w0[j] * uu; acc[1][j] += w1[j] * uu; acc[2][j] += w2[j] * uu; acc[3][j] += w3[j] * uu;
        }
    }
#pragma unroll
    for (int r = 0; r < 4; ++r) {
        const int row = r0 + 4 * wave + r; float s = 0.f;
#pragma unroll
        for (int j = 0; j < 6; ++j) { acc[r][j] += *(const f32x2*)(cb + 2 * lane + 128 * j); s += acc[r][j][0] + acc[r][j][1]; }
        const float mean = wave_sum(s) * (1.f / CW); float s2 = 0.f;
#pragma unroll
        for (int j = 0; j < 6; ++j) { acc[r][j] = acc[r][j] - mean; s2 += acc[r][j][0] * acc[r][j][0] + acc[r][j][1] * acc[r][j][1]; }
        const float rstd = 1.f / sqrtf(wave_sum(s2) * (1.f / CW) + LN_EPS);
#pragma unroll
        for (int j = 0; j < 6; ++j) {
            const f32x2 gg = *(const f32x2*)(g + 2 * lane + 128 * j), bb = *(const f32x2*)(b + 2 * lane + 128 * j);
            f32x2 y = acc[r][j] * rstd * gg + bb; y[0] = y[0] * sigmoidf_fast(y[0]); y[1] = y[1] * sigmoidf_fast(y[1]);
            *(unsigned*)(Y + (size_t)row * MIXW + 2 * lane + 128 * j) = cvt_pk_bf16(y[0], y[1]);
        }
    }
    __syncthreads();
}

__device__ __forceinline__ void attn_unit(const bf16_t* Q, const bf16_t* Kb, const bf16_t* VT, bf16_t* Y, const float* sinks, int qb, int kvh, int lane) {
    const int fr = lane & 15, fq = lane >> 4, q0 = qb * 16, kstart = (q0 - 128) & ~31, qpos = q0 + fr;
    const unsigned klane = (unsigned)(fr * KVW + fq * 8) * 2u, qlane = (unsigned)(fr * AW + fq * 8) * 2u, vlane = (unsigned)(fr * S + fq * 8) * 2u, ylane = (unsigned)(fr * MIXW + fq * 4) * 2u;
    bf16x8 kf[10][2];
#pragma unroll
    for (int kt = 0; kt < 10; ++kt) {
        int kb = kstart + kt * 16; kb = kb < 0 ? 0 : kb;
        const char* kp = (const char*)Kb + ((size_t)kb * KVW + kvh * HD) * 2;
        kf[kt][0] = *(const bf16x8*)(kp + klane); kf[kt][1] = *(const bf16x8*)(kp + 64 + klane);
    }
    const char* qbase = (const char*)Q + ((size_t)q0 * AW + kvh * 6 * HD) * 2;
    bf16x8 qn0 = *(const bf16x8*)(qbase + qlane), qn1 = *(const bf16x8*)(qbase + 64 + qlane);
#pragma unroll 1
    for (int g = 0; g < 6; ++g) {
        const int h = kvh * 6 + g;
        const bf16x8 qf0 = qn0, qf1 = qn1;
        if (g < 5) { qn0 = *(const bf16x8*)(qbase + (g + 1) * HD * 2 + qlane); qn1 = *(const bf16x8*)(qbase + (g + 1) * HD * 2 + 64 + qlane); }
        const float slope = (h < 16) ? __builtin_amdgcn_exp2f(-0.5f * (float)(h + 1)) : __builtin_amdgcn_exp2f(-0.25f * (float)(2 * (h - 16) + 1));
        const float slope2 = slope * L2E, sink2 = sinks[h] * L2E;
        f32x4 s[10];
#pragma unroll
        for (int kt = 0; kt < 10; ++kt) {
            f32x4 z = (f32x4){0.f, 0.f, 0.f, 0.f};
            z = __builtin_amdgcn_mfma_f32_16x16x32_bf16(kf[kt][0], qf0, z, 0, 0, 0);
            z = __builtin_amdgcn_mfma_f32_16x16x32_bf16(kf[kt][1], qf1, z, 0, 0, 0);
            s[kt] = z;
        }
        float mx = sink2;
#pragma unroll
        for (int kt = 0; kt < 10; ++kt)
#pragma unroll
            for (int i = 0; i < 4; ++i) {
                const int key = kstart + kt * 16 + fq * 4 + i, dist = qpos - key;
                const bool valid = (dist >= 0) && (dist < 128) && (key >= 0);
                const float v = valid ? (s[kt][i] - slope2 * (float)dist) : -__builtin_inff();
                s[kt][i] = v; mx = fmaxf(mx, v);
            }
        mx = fmaxf(mx, __shfl_xor(mx, 16)); mx = fmaxf(mx, __shfl_xor(mx, 32));
        float sum = 0.f;
#pragma unroll
        for (int kt = 0; kt < 10; ++kt)
#pragma unroll
            for (int i = 0; i < 4; ++i) { const float p = __builtin_amdgcn_exp2f(s[kt][i] - mx); s[kt][i] = p; sum += p; }
        sum += __shfl_xor(sum, 16); sum += __shfl_xor(sum, 32);
        sum += __builtin_amdgcn_exp2f(sink2 - mx);
        const float inv = 1.f / sum;
        bf16x8 pf[5];
#pragma unroll
        for (int c = 0; c < 5; ++c) pf[c] = __builtin_bit_cast(bf16x8, pg8::pack8(s[2 * c], s[2 * c + 1]));
        char* ybase = (char*)Y + ((size_t)q0 * MIXW + 2 * CW + h * HD) * 2;
#pragma unroll
        for (int dt = 0; dt < 4; ++dt) {
            bf16x8 vf[5];
#pragma unroll
            for (int c = 0; c < 5; ++c) { int kb = kstart + 32 * c; kb = kb < 0 ? 0 : kb; vf[c] = *(const bf16x8*)((const char*)VT + ((size_t)(kvh * HD + dt * 16) * S + kb) * 2 + vlane); }
            f32x4 o = (f32x4){0.f, 0.f, 0.f, 0.f};
#pragma unroll
            for (int c = 0; c < 5; ++c) o = __builtin_amdgcn_mfma_f32_16x16x32_bf16(vf[c], pf[c], o, 0, 0, 0);
            o = o * inv;
            *(u32x2*)(ybase + dt * 32 + ylane) = (u32x2){cvt_pk_bf16(o[0], o[1]), cvt_pk_bf16(o[2], o[3])};
        }
    }
}

constexpr int NPH = 9, NPHASES = DEPTH * NPH;
struct Args { const float* in[20]; float* out; unsigned char* ws; int ph_lo, ph_hi, one, pad; };
typedef const __attribute__((address_space(4))) Args* CArgsP;
#ifndef PH_MASK
#define PH_MASK 0x1ff
#endif
#ifndef PROBE_DUP
#define PROBE_DUP 0
#endif
#define DUPN(k) (1 + ((PROBE_DUP >> (k)) & 1))

#define PHASE_BEGIN() CArgsP p = ap; asm volatile("" : "+s"(p)); int tz = threadIdx.x; asm volatile("" : "+v"(tz)); \
    const int lane = tz & 63, wave = __builtin_amdgcn_readfirstlane(tz >> 6); unsigned char* ws = p->ws; (void)lane; (void)wave; (void)ws; \
    const int G = gridDim.x, bx = blockIdx.x, vcu = (G % 8 == 0) ? (bx % 8) * (G / 8) + bx / 8 : bx, NGW = G * 8, NGT = G * 512; (void)NGW; (void)NGT; (void)vcu
#define GW() (vcu * 8 + wave)
#define GTID() (vcu * 512 + tz)

__global__ void __launch_bounds__(512, 2) fwd(Args a_unused) {
    extern __shared__ __attribute__((aligned(16))) unsigned char lds_raw[];
    LAS unsigned char* lds = (LAS unsigned char*)lds_raw;
    const CArgsP ap = (CArgsP)__builtin_amdgcn_kernarg_segment_ptr();
    for (int u = threadIdx.x; u < (LDS_BYTES - RING_BYTES) / 4; u += 512) ((LAS unsigned*)(lds + RING_BYTES))[u] = 0u;
    __syncthreads();
    if (ap->one) (void)xcd_barrier_post((unsigned*)(ap->ws + WS_CTL) + CW_BAR, (volatile LAS unsigned*)(lds + MISC_OFF) + 8);
#define IN(k) (((PH_MASK >> ((k) % NPH)) & 1) && ap->ph_lo <= (k) && (k) < ap->ph_hi)
#define GRID_BAR(k) do { if (IN(k) && IN((k) + 1)) { XcdBarrier xb_; xb_.bar = (unsigned*)(ws + WS_CTL) + CW_BAR; xb_.x = xb_xcc_id(); xb_.st = (volatile LAS unsigned*)(lds + MISC_OFF) + 8; xcd_barrier(xb_); } } while (0)

    for (int l = 0; l < DEPTH; ++l) {
        const int pb = l * NPH;
        if (IN(pb + 0)) for (int dup_ = 0; dup_ < DUPN(0); ++dup_) {
            PHASE_BEGIN();
            const LayerW W = layer_w(ws, l);
            convert_phase(p->in[1] + (size_t)l * D * NIN, p->in[9] + (size_t)l * MIXW * D, p->in[10] + (size_t)l * D * D, p->in[14] + (size_t)l * D * FF, p->in[16] + (size_t)l * FF * D,
                          p->in[2] + (size_t)l * NIN, W, (float*)(ws + WS_BIASP + (size_t)l * 131072), lds, GW(), NGW, wave, lane, GTID(), NGT);
            if (l == 0) cvt_rows_phase(p->in[0], (bf16_t*)(ws + WS_XB), ws + WS_XQ, GTID(), NGT);
            GRID_BAR(pb + 0);
        }
        if (IN(pb + 1)) for (int dup_ = 0; dup_ < DUPN(1); ++dup_) {
            PHASE_BEGIN();
            const LayerW W = layer_w(ws, l);
            if (INPROJ_BF16_PART) {
              { pg8::Gemm g{ws + WS_XB, W.WinT, D * 2, D * 2, D / 64}; pg8::StaticOrder So; So.init(S, NBF2, G, bx);
                pg8::EpiInProj E{(const float*)(ws + WS_BIASP + (size_t)l * 131072), (bf16_t*)(ws + WS_U), (bf16_t*)(ws + WS_CX), (bf16_t*)(ws + WS_SB), (bf16_t*)(ws + WS_Q), (bf16_t*)(ws + WS_K), (bf16_t*)(ws + WS_VT), (bf16_t*)(ws + WS_SG), 1.f, 0};
                pg8::gemm_phase<pg8::EpiInProj, false>(lds, g, So, E, tz); }
              { pg8::Gemm g{ws + WS_XQ, W.WgQ + (size_t)NBF2 * D, D, D, D / 128}; pg8::BalancedOrder So;
                const int extra = (S / 256) * (NBF2 / 256) - G;
                if (extra > 0 && extra < G) So.init(S, NIN - NBF2, G, bx, ((S / 256) * ((NIN - NBF2) / 256) - 2 * (G - extra)) / G, extra); else So.init(S, NIN - NBF2, G, bx, 1 << 20, 0);
                pg8::EpiInProj E{(const float*)(ws + WS_BIASP + (size_t)l * 131072), (bf16_t*)(ws + WS_U), (bf16_t*)(ws + WS_CX), (bf16_t*)(ws + WS_SB), (bf16_t*)(ws + WS_Q), (bf16_t*)(ws + WS_K), (bf16_t*)(ws + WS_VT), (bf16_t*)(ws + WS_SG), GQ_DESCALE, NBF2 / 256};
                pg8::gemm_phase<pg8::EpiInProj, false, true, pg8::BalancedOrder>(lds, g, So, E, tz); }
            } else {
              pg8::Gemm g{ws + WS_XQ, W.WgQ, D, D, D / 128}; pg8::StaticOrder So; So.init(S, NIN, G, bx);
              pg8::EpiInProj E{(const float*)(ws + WS_BIASP + (size_t)l * 131072), (bf16_t*)(ws + WS_U), (bf16_t*)(ws + WS_CX), (bf16_t*)(ws + WS_SB), (bf16_t*)(ws + WS_Q), (bf16_t*)(ws + WS_K), (bf16_t*)(ws + WS_VT), (bf16_t*)(ws + WS_SG), GQ_DESCALE, 0};
              pg8::gemm_phase<pg8::EpiInProj, false, true>(lds, g, So, E, tz);
            }
            GRID_BAR(pb + 1);
        }
        if (IN(pb + 2)) for (int dup_ = 0; dup_ < DUPN(2); ++dup_) {
            PHASE_BEGIN();
            bf16_t* Yb = (bf16_t*)(ws + WS_Y);
            for (int un = vcu; un < S / 32; un += G)
                convA_unit((const bf16_t*)(ws + WS_U), p->in[3] + (size_t)l * 31 * CW, p->in[4] + (size_t)l * CW, p->in[5] + (size_t)l * CW, p->in[6] + (size_t)l * CW, Yb, un * 32, lds, tz, wave, lane);
            convB_phase((const bf16_t*)(ws + WS_CX), (const bf16_t*)(ws + WS_SB), p->in[7] + (size_t)l * 3 * CW, Yb, GTID(), NGT);
            for (int it = GW(); it < (S / 16) * 4; it += NGW)
                attn_unit((const bf16_t*)(ws + WS_Q), (const bf16_t*)(ws + WS_K), (const bf16_t*)(ws + WS_VT), Yb, p->in[8] + (size_t)l * NQH, __builtin_amdgcn_readfirstlane(it % (S / 16)), __builtin_amdgcn_readfirstlane(it / (S / 16)), lane);
            GRID_BAR(pb + 2);
        }
        if (IN(pb + 3)) for (int dup_ = 0; dup_ < DUPN(3); ++dup_) {
            PHASE_BEGIN();
            const LayerW W = layer_w(ws, l);
            pg8::Gemm g{ws + WS_Y, W.WbT, MIXW * 2, MIXW * 2, MIXW / 64}; pg8::StaticOrder So; So.init(S, D, G, bx);
            pg8::EpiMerge E{(const bf16_t*)(ws + WS_SG), (bf16_t*)(ws + WS_MG)};
            pg8::gemm_phase<pg8::EpiMerge, true>(lds, g, So, E, tz);
            GRID_BAR(pb + 3);
        }
        if (IN(pb + 4)) for (int dup_ = 0; dup_ < DUPN(4); ++dup_) {
            PHASE_BEGIN();
            const LayerW W = layer_w(ws, l);
            pg8::StaticOrder So; So.init(S, D, G, bx);
            if (OUTPROJ_FP8) { pg8::Gemm g{ws + WS_MG, W.WoT, D, D, D / 128};
              pg8::EpiResid E{l == 0 ? p->in[0] : (const float*)(ws + WS_XF), p->in[11] + (size_t)l * D, (float*)(ws + WS_V), OQ_DESCALE};
              pg8::gemm_phase<pg8::EpiResid, false, true>(lds, g, So, E, tz); }
            else { pg8::Gemm g{ws + WS_MG, W.WoT, D * 2, D * 2, D / 64};
              pg8::EpiResid E{l == 0 ? p->in[0] : (const float*)(ws + WS_XF), p->in[11] + (size_t)l * D, (float*)(ws + WS_V), 1.f};
              pg8::gemm_phase<pg8::EpiResid, false>(lds, g, So, E, tz); }
            GRID_BAR(pb + 4);
        }
        if (IN(pb + 5)) for (int dup_ = 0; dup_ < DUPN(5); ++dup_) {
            PHASE_BEGIN();
            ln_phase((const float*)(ws + WS_V), p->in[12] + (size_t)l * D, p->in[13] + (size_t)l * D, (float*)(ws + WS_X1F), (bf16_t*)(ws + WS_X1B), nullptr, GW(), NGW, lane);
            GRID_BAR(pb + 5);
        }
        if (IN(pb + 6)) for (int dup_ = 0; dup_ < DUPN(6); ++dup_) {
            PHASE_BEGIN();
            const LayerW W = layer_w(ws, l);
            pg8::Gemm g{ws + WS_X1B, W.W1T, D * 2, D * 2, D / 64}; pg8::StaticOrder So; So.init(S, FF, G, bx);
            pg8::EpiRelu2 E{p->in[15] + (size_t)l * FF, (bf16_t*)(ws + WS_HID)};
            pg8::gemm_phase<pg8::EpiRelu2, false>(lds, g, So, E, tz);
            GRID_BAR(pb + 6);
        }
        if (IN(pb + 7)) for (int dup_ = 0; dup_ < DUPN(7); ++dup_) {
            PHASE_BEGIN();
            const LayerW W = layer_w(ws, l);
            pg8::Gemm g{ws + WS_HID, W.W2T, FF * 2, FF * 2, FF / 64}; pg8::StaticOrder So; So.init(S, D, G, bx);
            pg8::EpiResid E{(const float*)(ws + WS_X1F), p->in[17] + (size_t)l * D, (float*)(ws + WS_V), 1.f};
            pg8::gemm_phase<pg8::EpiResid, false>(lds, g, So, E, tz);
            GRID_BAR(pb + 7);
        }
        if (IN(pb + 8)) for (int dup_ = 0; dup_ < DUPN(8); ++dup_) {
            PHASE_BEGIN();
            ln_phase((const float*)(ws + WS_V), p->in[18] + (size_t)l * D, p->in[19] + (size_t)l * D, l == DEPTH - 1 ? p->out : (float*)(ws + WS_XF), INPROJ_BF16_PART ? (bf16_t*)(ws + WS_XB) : (bf16_t*)nullptr, ws + WS_XQ, GW(), NGW, lane);
            GRID_BAR(pb + 8);
        }
    }
#undef IN
#undef GRID_BAR
}

extern "C" void kernel_launch(void* const* d_in, const int* in_sizes, int n_in, void* d_out, int out_size, void* d_ws, size_t ws_size, hipStream_t stream) {
    static int grid = 0;
    if (grid == 0) {
        if (n_in != 20 || in_sizes[0] != S * D || out_size != S * D || ws_size < WS_END) {
            fprintf(stderr, "kernel_launch: unexpected shapes (n_in %d, in0 %d, out %d, ws %zu, need %zu); nothing launched\n", n_in, n_in > 0 ? in_sizes[0] : -1, out_size, ws_size, (size_t)WS_END); grid = -1; return; }
        int dev = 0, cus = 0, per_cu = 0;
        if (hipGetDevice(&dev) != hipSuccess || hipDeviceGetAttribute(&cus, hipDeviceAttributeMultiprocessorCount, dev) != hipSuccess) { grid = -1; return; }
        if (hipFuncSetAttribute((const void*)fwd, hipFuncAttributeMaxDynamicSharedMemorySize, LDS_BYTES) != hipSuccess) { fprintf(stderr, "kernel_launch: hipFuncSetAttribute failed\n"); grid = -1; return; }
        if (hipOccupancyMaxActiveBlocksPerMultiprocessor(&per_cu, (const void*)fwd, 512, LDS_BYTES) != hipSuccess || per_cu < 1) fprintf(stderr, "kernel_launch: occupancy query reports %d\n", per_cu);
        (void)hipGetLastError();
        grid = cus;
    }
    if (grid < 0) return;
    (void)hipMemsetAsync((char*)d_ws + WS_CTL, 0, CTL_ZERO_BYTES, stream);
    Args a{};
    for (int i = 0; i < 20; ++i) a.in[i] = (const float*)d_in[i];
    a.out = (float*)d_out; a.ws = (unsigned char*)d_ws; a.pad = 0;
#if MK_ONE_LAUNCH
    a.ph_lo = 0; a.ph_hi = NPHASES; a.one = 1;
    hipLaunchKernelGGL(fwd, dim3(grid), dim3(512), LDS_BYTES, stream, a);
#else
    a.one = 0;
    for (int p = 0; p < NPHASES; ++p) { a.ph_lo = p; a.ph_hi = p + 1; hipLaunchKernelGGL(fwd, dim3(grid), dim3(512), LDS_BYTES, stream, a); }
#endif
}
```
